# Optimizing an MI355X kernel written in HIP

```python
import math
import jax, jax.numpy as jnp
from jax import lax
import numpy as np

D_MODEL = 1024
BATCH = 8
SEQ = 2048
DEPTH = 4

A_HEADS = 4
A_HEAD_DIM = 128
IDX_HEADS = 8
IDX_DIM = 64
TOPK_MAX = 256
B_HEADS = 4
B_KEY_DIM = 128
B_VAL_DIM = 128
B_CHUNK = 64
C_HEADS = 4
C_Q_RANK = 384
C_KV_RANK = 256
C_NOPE = 128
C_ROPE = 64
C_V = 128
ROPE_THETA = 10000.0
REL_BUCKETS = 32
REL_MAX_DIST = 128
D_FF = -(-8 * D_MODEL // (3 * 256)) * 256
QBLOCK = 128
EPS = 1e-6
N_BRANCH = 3
NEG_BIG = -1e30
LB_FLOOR = 1e-30

A_WIDTH = A_HEADS * A_HEAD_DIM
B_WIDTH = B_HEADS * B_VAL_DIM
C_WIDTH = C_HEADS * C_V
IN_SPLITS = (A_HEADS * A_HEAD_DIM, A_HEAD_DIM, A_HEAD_DIM,
             IDX_HEADS * IDX_DIM, IDX_DIM, IDX_HEADS,
             B_HEADS * B_KEY_DIM, B_HEADS * B_KEY_DIM,
             B_HEADS * B_VAL_DIM, B_HEADS * B_VAL_DIM,
             C_Q_RANK, C_KV_RANK, C_ROPE,
             N_BRANCH * D_MODEL)
IN_COLS = sum(IN_SPLITS)

kernel_name = 'hybrid_dsa_hgrn2_mla_block'


def rms_norm(x, g):
    x32 = x.astype(jnp.float32)
    y = x32 * lax.rsqrt(jnp.mean(x32 * x32, axis=-1, keepdims=True) + EPS)
    return (y * g.astype(jnp.float32)).astype(x.dtype)


def apply_rope(x, cos, sin):
    x32 = x.astype(jnp.float32)
    x1, x2 = jnp.split(x32, 2, axis=-1)
    return jnp.concatenate([x1 * cos - x2 * sin, x2 * cos + x1 * sin], axis=-1).astype(x.dtype)


def t5_bucket(dist):
    max_exact = REL_BUCKETS // 2
    d = jnp.maximum(dist, 0)
    dl = jnp.maximum(d, max_exact).astype(jnp.float32)
    large = max_exact + (jnp.log(dl / max_exact) / math.log(REL_MAX_DIST / max_exact)
                         * (REL_BUCKETS - max_exact)).astype(jnp.int32)
    large = jnp.minimum(large, REL_BUCKETS - 1)
    return jnp.where(d < max_exact, d, large)


def dsa_attention(q, k, v, iq, ik, iw, positions, rel_bias):
    bsz, s_len = q.shape[0], q.shape[1]
    topk = min(TOPK_MAX, s_len // 4)
    n_blk = s_len // QBLOCK
    key_idx = jnp.arange(s_len)
    scale = A_HEAD_DIM ** -0.5
    idx_scale = (IDX_DIM ** -0.5) * (IDX_HEADS ** -0.5)
    ik32 = ik.astype(jnp.float32)
    gather = jax.vmap(lambda arr, ix: arr[ix])

    def block(i):
        start = i * QBLOCK
        qb = lax.dynamic_slice_in_dim(q, start, QBLOCK, axis=1)
        iqb = lax.dynamic_slice_in_dim(iq, start, QBLOCK, axis=1).astype(jnp.float32)
        iwb = lax.dynamic_slice_in_dim(iw, start, QBLOCK, axis=1).astype(jnp.float32)
        pb = lax.dynamic_slice_in_dim(positions, start, QBLOCK, axis=1)
        t_idx = start + jnp.arange(QBLOCK)
        causal = key_idx[None, :] <= t_idx[:, None]
        logits = jnp.einsum('bthd,bsd->bths', iqb, ik32)
        score = jnp.einsum('bths,bth->bts', jax.nn.relu(logits), iwb) * idx_scale
        score = jnp.where(causal[None], score, NEG_BIG)
        _, sel = lax.top_k(score, topk)
        k_sel = gather(k, sel)
        v_sel = gather(v, sel)
        p_sel = gather(positions, sel)
        bias = rel_bias[t5_bucket(pb[:, :, None] - p_sel)]
        s = (jnp.einsum('bthd,btkd->bthk', qb, k_sel).astype(jnp.float32) * scale
             + jnp.moveaxis(bias, -1, 2).astype(jnp.float32))
        valid = sel <= t_idx[None, :, None]
        s = jnp.where(valid[:, :, None, :], s, NEG_BIG)
        p = jax.nn.softmax(s, axis=-1).astype(v.dtype)
        return jnp.einsum('bthk,btkd->bthd', p, v_sel)

    out = lax.map(block, jnp.arange(n_blk))
    return jnp.moveaxis(out, 0, 1).reshape(bsz, s_len, A_WIDTH)


def hgrn2_mixer(q, f_raw, inp, g, lb, out_gain):
    bsz, s_len = q.shape[0], q.shape[1]
    f32 = jnp.float32
    n_chunk = s_len // B_CHUNK
    fr = f_raw.astype(f32)
    log_lb = jnp.log(jnp.maximum(lb, LB_FLOOR))
    log_f = jnp.logaddexp(log_lb, jnp.log1p(-lb) + jax.nn.log_sigmoid(fr))
    k_in = (1.0 - lb) * jax.nn.sigmoid(-fr)
    q_s = q.astype(f32) * (B_KEY_DIM ** -0.5)

    def chunks(t, d):
        return t.astype(f32).reshape(bsz, n_chunk, B_CHUNK, B_HEADS, d).transpose(1, 0, 3, 2, 4)

    causal = jnp.tril(jnp.ones((B_CHUNK, B_CHUNK), dtype=bool))

    def step(state, xs):
        qc, kc, vc, lfc = xs
        b = jnp.cumsum(lfc, axis=2)
        o_inter = jnp.einsum('bhck,bhkv->bhcv', qc * jnp.exp(b), state)
        diff = b[:, :, :, None, :] - b[:, :, None, :, :]
        decay = jnp.exp(jnp.where(causal[None, None, :, :, None], diff, NEG_BIG))
        attn = jnp.einsum('bhtk,bhsk,bhtsk->bhts', qc, kc, decay)
        o_intra = jnp.einsum('bhts,bhsv->bhtv', attn, vc)
        b_last = b[:, :, -1:, :]
        new_state = (jnp.exp(b_last[:, :, 0, :])[..., None] * state
                     + jnp.einsum('bhsk,bhsv->bhkv', kc * jnp.exp(b_last - b), vc))
        return new_state, o_inter + o_intra

    xs = (chunks(q_s, B_KEY_DIM), chunks(k_in, B_KEY_DIM), chunks(inp, B_VAL_DIM), chunks(log_f, B_KEY_DIM))
    state0 = jnp.zeros((bsz, B_HEADS, B_KEY_DIM, B_VAL_DIM), f32)
    _, o = lax.scan(step, state0, xs)
    o = o.transpose(1, 0, 3, 2, 4).reshape(bsz, s_len, B_HEADS, B_VAL_DIM)
    o = rms_norm(o, out_gain) * jax.nn.silu(g.astype(f32).reshape(bsz, s_len, B_HEADS, B_VAL_DIM))
    return o.reshape(bsz, s_len, B_WIDTH).astype(q.dtype)


def mla_attention(q_nope, q_pe, k_nope, k_pe, v):
    bsz, s_len = q_nope.shape[0], q_nope.shape[1]
    n_blk = s_len // QBLOCK
    scale = (C_NOPE + C_ROPE) ** -0.5
    key_idx = jnp.arange(s_len)

    def block(i):
        start = i * QBLOCK
        qn = lax.dynamic_slice_in_dim(q_nope, start, QBLOCK, axis=1)
        qp = lax.dynamic_slice_in_dim(q_pe, start, QBLOCK, axis=1)
        t_idx = start + jnp.arange(QBLOCK)
        causal = key_idx[None, :] <= t_idx[:, None]
        s = (jnp.einsum('bthd,bshd->bhts', qn, k_nope)
             + jnp.einsum('bthr,bsr->bhts', qp, k_pe)).astype(jnp.float32) * scale
        s = jnp.where(causal[None, None], s, NEG_BIG)
        p = jax.nn.softmax(s, axis=-1).astype(v.dtype)
        return jnp.einsum('bhts,bshd->bthd', p, v)

    out = lax.map(block, jnp.arange(n_blk))
    return jnp.moveaxis(out, 0, 1).reshape(bsz, s_len, C_WIDTH)


def setup_inputs(seed: int = 0) -> dict:
    key = jax.random.key(seed)
    ks = jax.random.split(key, 24)
    f32 = jnp.float32
    res_scale = (2 * DEPTH) ** -0.5

    def dense(k, shape, fan_in, scale=1.0):
        return jax.random.normal(k, shape, f32) * (scale * fan_in ** -0.5)

    def gain(k, shape):
        return 1.0 + 0.02 * jax.random.normal(k, shape, f32)

    x = jax.random.normal(ks[0], (BATCH, SEQ, D_MODEL), f32)
    offset = jax.random.randint(ks[1], (BATCH, 1), 0, 4096, dtype=jnp.int32)
    positions = offset + jnp.arange(SEQ, dtype=jnp.int32)[None, :]
    return {
        'x': x,
        'positions': positions,
        'w_in': dense(ks[2], (DEPTH, D_MODEL, IN_COLS), D_MODEL),
        'w_up_a': dense(ks[3], (DEPTH, A_WIDTH, D_MODEL), A_WIDTH),
        'w_up_b': dense(ks[4], (DEPTH, B_WIDTH, D_MODEL), B_WIDTH),
        'w_up_c': dense(ks[5], (DEPTH, C_WIDTH, D_MODEL), C_WIDTH),
        'w_out': dense(ks[6], (DEPTH, D_MODEL, D_MODEL), D_MODEL, res_scale),
        'mla_q_norm': gain(ks[7], (DEPTH, C_Q_RANK)),
        'mla_w_qb': dense(ks[8], (DEPTH, C_Q_RANK, C_HEADS * (C_NOPE + C_ROPE)), C_Q_RANK),
        'mla_kv_norm': gain(ks[9], (DEPTH, C_KV_RANK)),
        'mla_w_kvb': dense(ks[10], (DEPTH, C_KV_RANK, C_HEADS * (C_NOPE + C_V)), C_KV_RANK),
        'hgrn_lb_logits': 0.5 * jax.random.normal(ks[11], (DEPTH, B_HEADS * B_KEY_DIM), f32),
        'hgrn_out_norm': gain(ks[12], (DEPTH, B_VAL_DIM)),
        'rel_bias': 0.5 * jax.random.normal(ks[13], (REL_BUCKETS, A_HEADS), f32),
        'attn_norm': gain(ks[14], (DEPTH, D_MODEL)),
        'ffn_norm': gain(ks[15], (DEPTH, D_MODEL)),
        'w_ffn_gate': dense(ks[16], (DEPTH, D_MODEL, D_FF), D_MODEL),
        'w_ffn_up': dense(ks[17], (DEPTH, D_MODEL, D_FF), D_MODEL),
        'w_ffn_down': dense(ks[18], (DEPTH, D_FF, D_MODEL), D_FF, res_scale),
        'final_norm': gain(ks[19], (D_MODEL,)),
    }


def reference(x, positions, w_in, w_up_a, w_up_b, w_up_c, w_out, mla_q_norm, mla_w_qb, mla_kv_norm,
              mla_w_kvb, hgrn_lb_logits, hgrn_out_norm, rel_bias, attn_norm, ffn_norm, w_ffn_gate,
              w_ffn_up, w_ffn_down, final_norm):
    bsz, s_len, _ = x.shape
    f32 = jnp.float32
    split_pts = np.cumsum(IN_SPLITS)[:-1].tolist()
    p_lb = jax.nn.softmax(hgrn_lb_logits.astype(f32), axis=0)
    lower_bounds = jnp.cumsum(p_lb, axis=0) - p_lb[0:1]
    inv_freq = ROPE_THETA ** (-jnp.arange(0, C_ROPE, 2, dtype=f32) / C_ROPE)
    ang = positions.astype(f32)[..., None] * inv_freq
    cos, sin = jnp.cos(ang), jnp.sin(ang)

    for l in range(DEPTH):
        h = rms_norm(x, attn_norm[l])
        proj = h @ w_in[l]
        (aq, ak, av, iq, ik, iw, bq, bf, bi, bg, cq, ckv, ckpe, gate_logits) = jnp.split(proj, split_pts, axis=-1)
        o_a = dsa_attention(aq.reshape(bsz, s_len, A_HEADS, A_HEAD_DIM), ak, av,
                            iq.reshape(bsz, s_len, IDX_HEADS, IDX_DIM), ik, iw, positions, rel_bias)
        o_b = hgrn2_mixer(bq, bf, bi, bg, lower_bounds[l], hgrn_out_norm[l])
        q_c = (rms_norm(cq, mla_q_norm[l]) @ mla_w_qb[l]).reshape(bsz, s_len, C_HEADS, C_NOPE + C_ROPE)
        q_nope, q_pe = q_c[..., :C_NOPE], q_c[..., C_NOPE:]
        kv_c = (rms_norm(ckv, mla_kv_norm[l]) @ mla_w_kvb[l]).reshape(bsz, s_len, C_HEADS, C_NOPE + C_V)
        k_nope, v_c = kv_c[..., :C_NOPE], kv_c[..., C_NOPE:]
        q_pe = apply_rope(q_pe, cos[:, :, None, :], sin[:, :, None, :])
        k_pe = apply_rope(ckpe, cos, sin)
        o_c = mla_attention(q_nope, q_pe, k_nope, k_pe, v_c)
        gates = jax.nn.sigmoid(gate_logits.astype(f32)).astype(x.dtype)
        g_a, g_b, g_c = jnp.split(gates, N_BRANCH, axis=-1)
        mixed = g_a * (o_a @ w_up_a[l]) + g_b * (o_b @ w_up_b[l]) + g_c * (o_c @ w_up_c[l])
        x = x + mixed @ w_out[l]
        h = rms_norm(x, ffn_norm[l])
        x = x + (jax.nn.silu(h @ w_ffn_gate[l]) * (h @ w_ffn_up[l])) @ w_ffn_down[l]

    return rms_norm(x, final_norm)
```

```cpp
#include <hip/hip_runtime.h>
#include <cstdio>
#include <cstdint>

#define LAS __attribute__((address_space(3)))
typedef _Float16 h16;
typedef _Float16 h16x8 __attribute__((ext_vector_type(8)));
typedef _Float16 h16x4 __attribute__((ext_vector_type(4)));
typedef _Float16 h16x2 __attribute__((ext_vector_type(2)));
typedef short bf16x8 __attribute__((ext_vector_type(8)));
typedef short s16x4 __attribute__((ext_vector_type(4)));
typedef float f32x2 __attribute__((ext_vector_type(2)));
typedef float f32x4 __attribute__((ext_vector_type(4)));
typedef float f32x16 __attribute__((ext_vector_type(16)));
typedef unsigned u32x2 __attribute__((ext_vector_type(2)));
typedef unsigned u32x4 __attribute__((ext_vector_type(4)));

constexpr int NB = 8, SEQ = 2048, M = NB * SEQ, DM = 1024, NL = 4, NP = 7168, DFF = 2816, IN_COLS = 7176;
constexpr int NTHREADS = 512, NWAVES = 8;
constexpr float EPS = 1e-6f;
constexpr int C_AQ = 0, C_AK = 512, C_AV = 640, C_IQ = 768, C_BQ = 1280, C_BF = 1792, C_BI = 2304, C_BG = 2816, C_CQ = 3328, C_IK = 3712, C_KPE = 3776, C_CKV = 3840, C_G = 4096;
constexpr int C_OA = C_AQ, C_OB = C_BQ, C_OC = C_CQ;

constexpr size_t MiB = 1u << 20;
constexpr size_t WS_CTL = 0, CTL_BYTES = 1 * MiB;
constexpr size_t WS_WIN = 1 * MiB;
constexpr size_t WS_WUP = WS_WIN + 14 * MiB;
constexpr size_t WS_WOUT = WS_WUP + 3 * MiB;
constexpr size_t WS_WQB = WS_WOUT + 2 * MiB;
constexpr size_t WS_WKVB = WS_WQB + 1 * MiB;
constexpr size_t WS_WGU = WS_WKVB + 1 * MiB;
constexpr size_t WS_WDN = WS_WGU + 11 * MiB;
constexpr size_t WS_SMALL = WS_WDN + 6 * MiB;
constexpr size_t WS_RSA = WS_SMALL + 2 * MiB;
constexpr size_t WS_RSF = WS_RSA + 1 * MiB;
constexpr size_t WS_COS = WS_RSF + 1 * MiB;
constexpr size_t WS_SIN = WS_COS + 2 * MiB;
constexpr size_t WS_KPE = WS_SIN + 2 * MiB;
constexpr size_t WS_MASK = WS_KPE + 2 * MiB;
constexpr size_t WS_X16 = WS_MASK + 4 * MiB;
constexpr size_t WS_QC = WS_X16 + 32 * MiB;
constexpr size_t WS_KVC = WS_QC + 24 * MiB;
constexpr size_t WS_MIX = WS_QC;
constexpr size_t WS_ST = WS_KVC + 32 * MiB;
constexpr size_t WS_P = WS_ST + 32 * MiB;
constexpr size_t WS_ACT = WS_P;
constexpr size_t WS_END = WS_P + 224 * MiB;
static_assert(WS_END <= 440 * MiB, "workspace map");
constexpr size_t SM_WIW = 0, SM_LB = 32768, SM_RSTDQ = 65536, SM_RSTDKV = 131072, SM_IW = 196608, SM_DC = 786432;

constexpr int LDS_MISC = 151552;
constexpr int LDS_BYTES = LDS_MISC + 1024;

#define VM_WAIT() asm volatile("s_waitcnt vmcnt(0)" ::: "memory")
#define LDS_WAIT() asm volatile("s_waitcnt lgkmcnt(0)" ::: "memory")

__device__ __forceinline__ unsigned pkh(float lo, float hi) { h16x2 v; v.x = (h16)lo; v.y = (h16)hi; return __builtin_bit_cast(unsigned, v); }
__device__ __forceinline__ unsigned pkb(float lo, float hi) { unsigned r; asm volatile("v_cvt_pk_bf16_f32 %0, %1, %2" : "=v"(r) : "v"(lo), "v"(hi)); return r; }
__device__ __forceinline__ float bf2f(unsigned short b) { return __uint_as_float(((unsigned)b) << 16); }
__device__ __forceinline__ float wave_sum(float v) {
#pragma unroll
    for (int o = 1; o < 64; o <<= 1) v += __shfl_xor(v, o);
    return v;
}
__device__ __forceinline__ float sigmoidf_(float x) { return 1.0f / (1.0f + __expf(-x)); }
__device__ __forceinline__ int crow(int r, int hi) { return (r & 3) + 8 * (r >> 2) + 4 * hi; }

#define XB_TMO      128
#define XB_XCNT(j)  (256  + 64 * (j))
#define XB_XSUB(j)  (1280 + 64 * (j))
#define XB_XGEN(j)  (2304 + 64 * (j))
#define XB_TOP      3328
#define XB_TOPGEN   3392
#define XCD_BAR_WORDS 3456
#define XB_SPIN_CAP (1u << 18)
__device__ __forceinline__ unsigned xb_ld(unsigned* p)              { return __hip_atomic_load(p, __ATOMIC_RELAXED, __HIP_MEMORY_SCOPE_AGENT); }
__device__ __forceinline__ unsigned xb_add(unsigned* p, unsigned v) { return __hip_atomic_fetch_add(p, v, __ATOMIC_RELAXED, __HIP_MEMORY_SCOPE_AGENT); }
__device__ __forceinline__ unsigned xb_xcc_id() { return (unsigned)__builtin_amdgcn_s_getreg((3 << 11) | 20) & 0xFu; }
#define XB_SPIN(cond, bar) do { unsigned _sp = 0; while (cond) { __builtin_amdgcn_s_sleep(1); \
    if ((++_sp & 255u) == 0u) { if (xb_ld(&(bar)[XB_TMO])) break; if (_sp > XB_SPIN_CAP) { atomicAdd(&(bar)[XB_TMO], 1u); break; } } } } while (0)
struct XcdBarrier { unsigned* bar; unsigned x; volatile LAS unsigned* st; };
__device__ __forceinline__ XcdBarrier xcd_barrier_post(unsigned* bar, volatile LAS unsigned* st) {
    XcdBarrier b; b.bar = bar; b.x = xb_xcc_id(); b.st = st;
    if (threadIdx.x == 0) (void)xb_add(&bar[XB_XCNT(b.x)], 1u);
    return b;
}
__device__ __forceinline__ void xcd_barrier_complete(unsigned* bar, unsigned x, unsigned& nloc, unsigned& nx) {
    const unsigned G = gridDim.x * gridDim.y * gridDim.z;
    unsigned sum, cnt, mine, sp = 0u;
    for (;;) {
        sum = 0u; cnt = 0u; mine = 0u;
#pragma unroll
        for (unsigned j = 0; j < 16; ++j) { const unsigned c = xb_ld(&bar[XB_XCNT(j)]); sum += c; cnt += (c > 0u) ? 1u : 0u; mine = (j == x) ? c : mine; }
        if (sum == G) break;
        __builtin_amdgcn_s_sleep(1);
        if ((++sp & 255u) == 0u) { if (xb_ld(&bar[XB_TMO])) break; if (sp > XB_SPIN_CAP) { atomicAdd(&bar[XB_TMO], 1u); break; } }
    }
    nloc = mine > 0u ? mine : 1u; nx = cnt > 0u ? cnt : 1u;
}
__device__ __forceinline__ void xcd_barrier(const XcdBarrier& b, bool leader) {
    asm volatile("s_waitcnt vmcnt(0)" ::: "memory");
    __syncthreads();
    if (leader) {
        unsigned* bar = b.bar;
        __builtin_amdgcn_s_waitcnt(0);
        unsigned nloc = b.st[0], nx = b.st[1];
        if (nloc == 0u) { xcd_barrier_complete(bar, b.x, nloc, nx); b.st[0] = nloc; b.st[1] = nx; }
        const unsigned old = xb_add(&bar[XB_XSUB(b.x)], 1u);
        const unsigned gen = old / nloc;
        if (old + 1u == (gen + 1u) * nloc) {
            __builtin_amdgcn_fence(__ATOMIC_RELEASE, "agent");
            asm volatile("s_waitcnt vmcnt(0)" ::: "memory");
            const unsigned og = xb_add(&bar[XB_TOP], 1u);
            const unsigned tg = og / nx;
            if (og + 1u == (tg + 1u) * nx) xb_add(&bar[XB_TOPGEN], 1u);
            else XB_SPIN(xb_ld(&bar[XB_TOPGEN]) == tg, bar);
            __builtin_amdgcn_fence(__ATOMIC_ACQUIRE, "agent");
            xb_add(&bar[XB_XGEN(b.x)], 1u);
            asm volatile("s_waitcnt vmcnt(0)" ::: "memory");
        } else {
            XB_SPIN(xb_ld(&bar[XB_XGEN(b.x)]) == gen, bar);
            __builtin_amdgcn_fence(__ATOMIC_ACQUIRE, "agent");
            asm volatile("s_waitcnt vmcnt(0)" ::: "memory");
        }
    }
    __syncthreads();
}

__device__ __forceinline__ int lane_id() { return (int)__builtin_amdgcn_mbcnt_hi(~0u, __builtin_amdgcn_mbcnt_lo(~0u, 0u)); }
__device__ __noinline__ void xcd_barrier_call(unsigned* barw, unsigned x, volatile LAS unsigned* st, int wave) { XcdBarrier b; b.bar = barw; b.x = x; b.st = st; xcd_barrier(b, wave == 0 && lane_id() == 0); }
namespace pg8 {
constexpr int BM = 256, BK = 64, HALF = 128, HTB = HALF * BK * 2, STAGE_BYTES = 8 * HTB, NXCD = 8, WGM = 8;
__host__ __device__ __forceinline__ int lds_byte(int r, int c) { const int st = (r >> 4) * 2 + (c >> 5), rr = r & 15, cc = c & 31, ob = rr * 64 + cc * 2; return st * 1024 + (ob ^ (((ob >> 9) & 1) << 5)); }
__host__ __device__ __forceinline__ void stage_rc(int b, int& R, int& C) { const int st = b / 1024, sb = b % 1024, swz = sb ^ (((sb >> 9) & 1) << 5); R = (st >> 1) * 16 + swz / 64; C = (st & 1) * 32 + (swz % 64) / 2; }
__host__ __device__ __forceinline__ int perm32(int rho) { const int n = rho >> 4, i = rho & 15; return 8 * (i >> 2) + 4 * n + (i & 3); }

struct Unit { const char* A; const char* B; int pm, pn, br; };
struct TileOrder {
    int nM, nN, nwg, G, c, nbr;
    __device__ __forceinline__ void init(int M_, int N_, int G_, int c_, int nbr_ = 1) { nM = M_ / BM; nN = N_ / BM; nwg = nM * nN; G = G_; c = c_; nbr = nbr_; }
    __device__ __forceinline__ bool tile(int i, int& pm, int& pn, int& br) const {
        const int it = i / nbr; br = i - it * nbr;
        const long L = (long)it * G + c; if (L >= nwg) return false;
        int wgid = (int)L; { const int q = nwg / NXCD, r = nwg % NXCD, xcd = wgid % NXCD, off = wgid / NXCD; wgid = (xcd < r ? xcd * (q + 1) : r * (q + 1) + (xcd - r) * q) + off; }
        const int nig = WGM * nN, gid = wgid / nig, fm = gid * WGM, gsz = (nM - fm) < WGM ? (nM - fm) : WGM;
        pm = fm + ((wgid % nig) % gsz); pn = (wgid % nig) / gsz; return true;
    }
};
struct PlainSched {
    TileOrder T; const char* A; const char* B; size_t lda2, ldb2;
    __device__ __forceinline__ bool next(int i, Unit& u) const { int pm, pn, br; if (!T.tile(i, pm, pn, br)) return false; u.pm = pm; u.pn = pn; u.br = br; u.A = A + (size_t)pm * BM * lda2; u.B = B + (size_t)pn * BM * ldb2; return true; }
};
struct BranchSched {
    TileOrder T; const char* A; const char* B; size_t lda2, ldb2; size_t b_stride;
    __device__ __forceinline__ bool next(int i, Unit& u) const { int pm, pn, br; if (!T.tile(i, pm, pn, br)) return false; u.pm = pm; u.pn = pn; u.br = br;
        const int ao = (br == 0) ? (C_OA * 2) : ((br == 1) ? (C_OB * 2) : (C_OC * 2));
        u.A = A + (size_t)pm * BM * lda2 + ao; u.B = B + (size_t)br * b_stride + (size_t)pn * BM * ldb2; return true; }
};

template <class Epi, class Sched>
__device__ __forceinline__ void gemm_phase(LAS unsigned char* lds, const int tid_in, const int K, const size_t lda2, const size_t ldb2, const Sched& S, const Epi& E) {
    int tid = tid_in; asm volatile("" : "+v"(tid));
    const int wid = __builtin_amdgcn_readfirstlane(tid >> 6), lane = tid & 63, wr = wid >> 2, wc = wid & 3, fr = lane & 15, fq = lane >> 4;
    const int nt = K / BK;
    unsigned voffA[2], voffB[2];
#pragma unroll
    for (int i = 0; i < 2; ++i) { int R, C; stage_rc(tid * 16 + i * 8192, R, C); const int Rb = Epi::PERM ? ((R & ~31) + perm32(R & 31)) : R;
        voffA[i] = (unsigned)((size_t)R * lda2 + C * 2); voffB[i] = (unsigned)((size_t)Rb * ldb2 + C * 2); }
    const size_t kstep = (size_t)(BK * 2);
    const size_t hstepA = (size_t)HALF * lda2, hstepB = (size_t)HALF * ldb2;
    const unsigned ldsw = (unsigned)wid * 1024u;
    const int aoff = lds_byte(wr * 64 + fr, fq * 8), boff = lds_byte(wc * 32 + fr, fq * 8);
#define PG8_SA(b, h) (((b) * 2 + (h)) * HTB)
#define PG8_SB(b, h) ((4 + (b) * 2 + (h)) * HTB)
#define PG8_STAGE(bufoff, gbase, voff) do { _Pragma("unroll") for (int _i = 0; _i < 2; ++_i) \
        __builtin_amdgcn_global_load_lds((const unsigned*)((const char*)(gbase) + (voff)[_i]), (LAS unsigned*)(lds + (bufoff) + ldsw + _i * 8192), 16, 0, 0); } while (0)
#define PG8_LDA(dst, b, h) do { _Pragma("unroll") for (int m = 0; m < 4; ++m) _Pragma("unroll") for (int k = 0; k < 2; ++k) dst[m][k] = *(const LAS h16x8*)(lds + PG8_SA(b, h) + aoff + m * 2048 + k * 1024); } while (0)
#define PG8_LDB(dst, b, h) do { _Pragma("unroll") for (int n = 0; n < 2; ++n) _Pragma("unroll") for (int k = 0; k < 2; ++k) dst[n][k] = *(const LAS h16x8*)(lds + PG8_SB(b, h) + boff + n * 2048 + k * 1024); } while (0)
#define PG8_MMA(ai, bj, At, Bt) do { __builtin_amdgcn_s_setprio(1); _Pragma("unroll") for (int m = 0; m < 4; ++m) _Pragma("unroll") for (int n = 0; n < 2; ++n) _Pragma("unroll") for (int k = 0; k < 2; ++k) \
        acc[ai][bj][m][n] = __builtin_amdgcn_mfma_f32_16x16x32_f16(Bt[n][k], At[m][k], acc[ai][bj][m][n], 0, 0, 0); __builtin_amdgcn_s_setprio(0); } while (0)
#define PG8_WAIT_V(n) asm volatile("s_waitcnt vmcnt(" #n ")" ::: "memory")
#define PG8_WAIT_L(n) asm volatile("s_waitcnt lgkmcnt(" #n ")" ::: "memory")
#define PG8_BAR __builtin_amdgcn_s_barrier()
#define PG8_SCHED __builtin_amdgcn_sched_barrier(0)
    Unit cur, nxt; int ui = 0;
    if (!S.next(0, cur)) return;
    f32x4 acc[2][2][4][2];
#pragma unroll
    for (int a = 0; a < 2; ++a)
#pragma unroll
        for (int b = 0; b < 2; ++b)
#pragma unroll
            for (int m = 0; m < 4; ++m)
#pragma unroll
                for (int n = 0; n < 2; ++n) acc[a][b][m][n] = (f32x4){0.f, 0.f, 0.f, 0.f};
    h16x8 At[4][2], B0[2][2], B1[2][2];
    const char* cA = cur.A; const char* cB = cur.B;
    PG8_STAGE(PG8_SB(0, 0), cB, voffB); PG8_STAGE(PG8_SB(0, 1), cB + hstepB, voffB); PG8_STAGE(PG8_SA(0, 0), cA, voffA); PG8_STAGE(PG8_SA(0, 1), cA + hstepA, voffA);
    if (wr == 1) PG8_BAR;
    PG8_WAIT_V(2); PG8_BAR;
    PG8_STAGE(PG8_SB(1, 0), cB + kstep, voffB); PG8_STAGE(PG8_SA(1, 0), cA + kstep, voffA); PG8_STAGE(PG8_SB(1, 1), cB + hstepB + kstep, voffB);
    PG8_WAIT_V(6); PG8_BAR;
    for (;;) {
        const bool has_next = S.next(ui + 1, nxt);
        const char* nA = has_next ? nxt.A : cA; const char* nB = has_next ? nxt.B : cB;
        for (int t = 0; t < nt; t += 2) {
            const bool last = (t == nt - 2);
            const char* a1 = cA + (size_t)(t + 1) * kstep;
            const char* a2 = last ? nA : cA + (size_t)(t + 2) * kstep; const char* b2 = last ? nB : cB + (size_t)(t + 2) * kstep;
            const char* a3 = a2 + kstep; const char* b3 = b2 + kstep;
            PG8_LDB(B0, 0, 0); PG8_LDB(B1, 0, 1); PG8_SCHED; PG8_LDA(At, 0, 0); PG8_STAGE(PG8_SA(1, 1), a1 + hstepA, voffA);
            PG8_WAIT_V(8); PG8_WAIT_L(0); PG8_BAR; PG8_MMA(0, 0, At, B0); PG8_MMA(0, 1, At, B1); PG8_BAR; PG8_SCHED;
            PG8_LDA(At, 0, 1); PG8_STAGE(PG8_SB(0, 0), b2, voffB); PG8_STAGE(PG8_SB(0, 1), b2 + hstepB, voffB); PG8_STAGE(PG8_SA(0, 0), a2, voffA);
            PG8_WAIT_V(8); PG8_WAIT_L(0); PG8_BAR; PG8_MMA(1, 0, At, B0); PG8_MMA(1, 1, At, B1); PG8_BAR; PG8_SCHED;
            PG8_LDB(B0, 1, 0); PG8_LDB(B1, 1, 1); PG8_SCHED; PG8_LDA(At, 1, 0); PG8_STAGE(PG8_SA(0, 1), a2 + hstepA, voffA);
            PG8_WAIT_V(8); PG8_WAIT_L(0); PG8_BAR; PG8_MMA(0, 0, At, B0); PG8_MMA(0, 1, At, B1); PG8_BAR; PG8_SCHED;
            PG8_LDA(At, 1, 1); PG8_STAGE(PG8_SB(1, 0), b3, voffB); PG8_STAGE(PG8_SB(1, 1), b3 + hstepB, voffB); PG8_STAGE(PG8_SA(1, 0), a3, voffA);
            PG8_WAIT_V(8); PG8_WAIT_L(0); PG8_BAR; PG8_MMA(1, 0, At, B0); PG8_MMA(1, 1, At, B1); PG8_BAR; PG8_SCHED;
        }
        if (wr == 0) PG8_BAR;
        { unsigned z_ = 0u; asm volatile("" : "+v"(z_)); const int le = (int)__builtin_amdgcn_mbcnt_hi(~0u, __builtin_amdgcn_mbcnt_lo(~0u, z_));
          E(acc, cur, wr, wc, le & 15, le >> 4); }
        if (!has_next) break;
#pragma unroll
        for (int a = 0; a < 2; ++a)
#pragma unroll
            for (int b = 0; b < 2; ++b)
#pragma unroll
                for (int m = 0; m < 4; ++m)
#pragma unroll
                    for (int n = 0; n < 2; ++n) acc[a][b][m][n] = (f32x4){0.f, 0.f, 0.f, 0.f};
        cur = nxt; cA = nA; cB = nB; ++ui;
        if (wr == 1) PG8_BAR;
    }
    PG8_WAIT_V(0);
    PG8_BAR;
#undef PG8_SA
#undef PG8_SB
#undef PG8_STAGE
#undef PG8_LDA
#undef PG8_LDB
#undef PG8_MMA
#undef PG8_WAIT_V
#undef PG8_WAIT_L
#undef PG8_BAR
#undef PG8_SCHED
}

__device__ __forceinline__ float rstd_from_parts(const float* part, int row, float inv_n) {
    const f32x4* p = (const f32x4*)(part + (size_t)row * 16);
    const f32x4 a = p[0], b = p[1], c = p[2], d = p[3];
    const float s = ((a[0] + a[1]) + (a[2] + a[3])) + ((b[0] + b[1]) + (b[2] + b[3])) + ((c[0] + c[1]) + (c[2] + c[3])) + ((d[0] + d[1]) + (d[2] + d[3]));
    return __builtin_amdgcn_rsqf(s * inv_n + EPS);
}
struct EpiScaleParts {
    static constexpr bool PERM = true;
    h16* O; int ldc; const float* part;
    __device__ __forceinline__ void operator()(const f32x4 (&acc)[2][2][4][2], const Unit& u, int wr, int wc, int fr, int fq) const {
        const int row0 = u.pm * BM + wr * 64 + fr, col0 = u.pn * BM + wc * 32 + 8 * fq;
#pragma unroll
        for (int ai = 0; ai < 2; ++ai)
#pragma unroll
            for (int m = 0; m < 4; ++m) { const int row = row0 + ai * HALF + m * 16; const float rs = rstd_from_parts(part, row, 1.0f / 1024.0f);
                h16* rowp = O + (size_t)row * ldc + col0;
#pragma unroll
                for (int bj = 0; bj < 2; ++bj) { const f32x4 v0 = acc[ai][bj][m][0] * rs, v1 = acc[ai][bj][m][1] * rs;
                    u32x4 w; w.x = pkh(v0[0], v0[1]); w.y = pkh(v0[2], v0[3]); w.z = pkh(v1[0], v1[1]); w.w = pkh(v1[2], v1[3]);
                    *(u32x4*)(rowp + bj * HALF) = w; } }
    }
};
template <bool ROPE> struct EpiScaleRow {
    static constexpr bool PERM = true;
    h16* O; int ldc; const float* rstd; const float* cosT; const float* sinT;
    __device__ __forceinline__ void operator()(const f32x4 (&acc)[2][2][4][2], const Unit& u, int wr, int wc, int fr, int fq) const {
        const int row0 = u.pm * BM + wr * 64 + fr, col0 = u.pn * BM + wc * 32 + 8 * fq;
#pragma unroll
        for (int ai = 0; ai < 2; ++ai)
#pragma unroll
            for (int m = 0; m < 4; ++m) { const int row = row0 + ai * HALF + m * 16; const float rs = rstd[row];
                h16* rowp = O + (size_t)row * ldc + col0;
#pragma unroll
                for (int bj = 0; bj < 2; ++bj) { f32x4 v0 = acc[ai][bj][m][0] * rs, v1 = acc[ai][bj][m][1] * rs;
                    if (ROPE) { const int c = col0 + bj * HALF, cm = c % 192;
                        if (cm >= 128) { const int i0 = (cm - 128) >> 1;
                            const f32x4 cs = *(const f32x4*)(cosT + (size_t)row * 32 + i0), sn = *(const f32x4*)(sinT + (size_t)row * 32 + i0);
                            const f32x4 a = v0, b = v1;
                            v0[0] = a[0] * cs[0] - a[1] * sn[0]; v0[1] = a[1] * cs[0] + a[0] * sn[0];
                            v0[2] = a[2] * cs[1] - a[3] * sn[1]; v0[3] = a[3] * cs[1] + a[2] * sn[1];
                            v1[0] = b[0] * cs[2] - b[1] * sn[2]; v1[1] = b[1] * cs[2] + b[0] * sn[2];
                            v1[2] = b[2] * cs[3] - b[3] * sn[3]; v1[3] = b[3] * cs[3] + b[2] * sn[3]; } }
                    u32x4 w; w.x = pkh(v0[0], v0[1]); w.y = pkh(v0[2], v0[3]); w.z = pkh(v1[0], v1[1]); w.w = pkh(v1[2], v1[3]);
                    *(u32x4*)(rowp + bj * HALF) = w; }
                asm volatile("" ::: "memory"); }
    }
};
struct EpiGateAcc {
    static constexpr bool PERM = true;
    h16* O; const h16* G; int ldg;
    __device__ __forceinline__ void operator()(const f32x4 (&acc)[2][2][4][2], const Unit& u, int wr, int wc, int fr, int fq) const {
        const int row0 = u.pm * BM + wr * 64 + fr, col0 = u.pn * BM + wc * 32 + 8 * fq;
#pragma unroll
        for (int ai = 0; ai < 2; ++ai)
#pragma unroll
            for (int m = 0; m < 4; ++m) { const int row = row0 + ai * HALF + m * 16;
                h16* rowp = O + (size_t)row * 1024 + col0; const h16* gp = G + (size_t)row * ldg + u.br * 1024 + col0;
#pragma unroll
                for (int bj = 0; bj < 2; ++bj) { const h16x8 g = *(const h16x8*)(gp + bj * HALF);
                    f32x4 v0 = acc[ai][bj][m][0], v1 = acc[ai][bj][m][1];
#pragma unroll
                    for (int j = 0; j < 4; ++j) { v0[j] *= sigmoidf_((float)g[j]); v1[j] *= sigmoidf_((float)g[4 + j]); }
                    if (u.br != 0) { const h16x8 o = *(const h16x8*)(rowp + bj * HALF);
#pragma unroll
                        for (int j = 0; j < 4; ++j) { v0[j] += (float)o[j]; v1[j] += (float)o[4 + j]; } }
                    u32x4 w; w.x = pkh(v0[0], v0[1]); w.y = pkh(v0[2], v0[3]); w.z = pkh(v1[0], v1[1]); w.w = pkh(v1[2], v1[3]);
                    *(u32x4*)(rowp + bj * HALF) = w; }
                asm volatile("" ::: "memory"); }
    }
};
struct EpiResidual {
    static constexpr bool PERM = false;
    const float* base; float* X; h16* X16; float* part;
    __device__ __forceinline__ void operator()(const f32x4 (&acc)[2][2][4][2], const Unit& u, int wr, int wc, int fr, int fq) const {
        const int row0 = u.pm * BM + wr * 64 + fr, col0 = u.pn * BM + wc * 32 + 4 * fq;
#pragma unroll
        for (int ai = 0; ai < 2; ++ai)
#pragma unroll
            for (int m = 0; m < 4; ++m) { const int row = row0 + ai * HALF + m * 16; const size_t off = (size_t)row * 1024 + col0; float ss = 0.f;
#pragma unroll
                for (int bj = 0; bj < 2; ++bj)
#pragma unroll
                    for (int n = 0; n < 2; ++n) { const f32x4 bs = *(const f32x4*)(base + off + bj * HALF + n * 16); const f32x4 o = bs + acc[ai][bj][m][n];
                        *(f32x4*)(X + off + bj * HALF + n * 16) = o; ss += (o[0] * o[0] + o[1] * o[1]) + (o[2] * o[2] + o[3] * o[3]);
                        u32x2 w; w.x = pkh(o[0], o[1]); w.y = pkh(o[2], o[3]); *(u32x2*)(X16 + off + bj * HALF + n * 16) = w; }
                ss += __shfl_xor(ss, 16); ss += __shfl_xor(ss, 32);
                if (fq == 0) part[(size_t)row * 16 + u.pn * 4 + wc] = ss; }
    }
};
struct EpiSwiGLU {
    static constexpr bool PERM = true;
    h16* O; const float* part;
    __device__ __forceinline__ void operator()(const f32x4 (&acc)[2][2][4][2], const Unit& u, int wr, int wc, int fr, int fq) const {
        const int row0 = u.pm * BM + wr * 64 + fr, col0 = u.pn * HALF + wc * 32 + 8 * fq;
#pragma unroll
        for (int ai = 0; ai < 2; ++ai)
#pragma unroll
            for (int m = 0; m < 4; ++m) { const int row = row0 + ai * HALF + m * 16; const float rs = rstd_from_parts(part, row, 1.0f / 1024.0f);
                float o[8];
#pragma unroll
                for (int n = 0; n < 2; ++n)
#pragma unroll
                    for (int j = 0; j < 4; ++j) { const float g = acc[ai][0][m][n][j] * rs, up = acc[ai][1][m][n][j] * rs; o[n * 4 + j] = g * sigmoidf_(g) * up; }
                u32x4 w; w.x = pkh(o[0], o[1]); w.y = pkh(o[2], o[3]); w.z = pkh(o[4], o[5]); w.w = pkh(o[6], o[7]);
                *(u32x4*)(O + (size_t)row * DFF + col0) = w; }
    }
};
}
struct Args { const float* in[20]; float* out; unsigned char* ws; int ph_lo, ph_hi; };
struct Frame {
    LAS unsigned char* lds;
    int tid, lane, wave, G, bid;
    unsigned char* ws;
    float* out;
};
#define FIN(i) (args.in[i])
enum { I_X = 0, I_POS, I_WIN, I_WUPA, I_WUPB, I_WUPC, I_WOUT, I_QNORM, I_WQB, I_KVNORM, I_WKVB, I_LBLOG, I_ONORM, I_RELB, I_ANORM, I_FNORM, I_WFG, I_WFU, I_WFD, I_FINAL };

template <class ColMap>
__device__ __forceinline__ void transpose_item(const float* W, int ldw, int K, h16* WT, const float* gain, LAS float* scr, int item, int nblk, int lane, const ColMap& cm) {
    const int kb = item / nblk, nb = item % nblk, k0 = 64 * kb, n0 = 32 * nb;
    const int sc = cm(n0 + (lane & 31));
#pragma unroll 8
    for (int i = 0; i < 32; ++i) { const int kk = 2 * i + (lane >> 5); float v = W[(size_t)(k0 + kk) * ldw + sc]; if (gain) v *= gain[k0 + kk]; scr[kk * 33 + (lane & 31)] = v; }
    LDS_WAIT(); asm volatile("" ::: "memory");
    const int c = lane & 7;
#pragma unroll
    for (int j = 0; j < 4; ++j) { const int n = (lane >> 3) + 8 * j; const LAS float* s = scr + (8 * c) * 33 + n;
        u32x4 o; o.x = pkh(s[0 * 33], s[1 * 33]); o.y = pkh(s[2 * 33], s[3 * 33]); o.z = pkh(s[4 * 33], s[5 * 33]); o.w = pkh(s[6 * 33], s[7 * 33]);
        *(u32x4*)(WT + (size_t)(n0 + n) * K + k0 + 8 * c) = o; }
    LDS_WAIT(); asm volatile("" ::: "memory");
}
struct MapIn { __device__ int operator()(int n) const {
        if (n < 1280) return n; if (n < 3712) return n + 72; if (n < 3776) return n - 2432;
        if (n < 3840) { const int p = n - 3776; return 4040 + ((p & 1) * 32 + (p >> 1)); }
        if (n < 4096) return n - 56; return n + 8; } };
struct MapId { __device__ int operator()(int n) const { return n; } };
struct MapQb { __device__ int operator()(int n) const { const int h = n / 192, d = n % 192; if (d < 128) return n; const int p = d - 128; return h * 192 + 128 + ((p & 1) * 32 + (p >> 1)); } };
struct MapGU { __device__ int operator()(int n) const { const int u = n >> 8, w = n & 255; return 128 * u + (w & 127); } };

__device__ __forceinline__ void ph0_convert(Frame& F, const Args& args, int l) {
    LAS float* scr = (LAS float*)(F.lds + F.wave * 8704);
    const int gw = F.bid * NWAVES + F.wave, NGW = F.G * NWAVES;
    unsigned char* ws = F.ws;
    constexpr int I_IN = 16 * 224, I_UP = 8 * 32, I_OUT = 16 * 32, I_QB = 6 * 24, I_KVB = 4 * 32, I_GU = 16 * 176, I_DN = 44 * 32;
    constexpr int NIT = I_IN + 3 * I_UP + I_OUT + I_QB + I_KVB + I_GU + I_DN;
    for (int it = gw; it < NIT; it += NGW) {
        int r = it;
        if (r < I_IN) { transpose_item(FIN(I_WIN) + (size_t)l * DM * IN_COLS, IN_COLS, DM, (h16*)(ws + WS_WIN), FIN(I_ANORM) + l * DM, scr, r, 224, F.lane, MapIn()); continue; } r -= I_IN;
        if (r < 3 * I_UP) { const int br = r / I_UP; r -= br * I_UP; const float* W = (br == 0 ? FIN(I_WUPA) : (br == 1 ? FIN(I_WUPB) : FIN(I_WUPC))) + (size_t)l * 512 * DM;
            transpose_item(W, DM, 512, (h16*)(ws + WS_WUP) + (size_t)br * 1024 * 512, nullptr, scr, r, 32, F.lane, MapId()); continue; } r -= 3 * I_UP;
        if (r < I_OUT) { transpose_item(FIN(I_WOUT) + (size_t)l * DM * DM, DM, DM, (h16*)(ws + WS_WOUT), nullptr, scr, r, 32, F.lane, MapId()); continue; } r -= I_OUT;
        if (r < I_QB) { transpose_item(FIN(I_WQB) + (size_t)l * 384 * 768, 768, 384, (h16*)(ws + WS_WQB), FIN(I_QNORM) + l * 384, scr, r, 24, F.lane, MapQb()); continue; } r -= I_QB;
        if (r < I_KVB) { transpose_item(FIN(I_WKVB) + (size_t)l * 256 * 1024, 1024, 256, (h16*)(ws + WS_WKVB), FIN(I_KVNORM) + l * 256, scr, r, 32, F.lane, MapId()); continue; } r -= I_KVB;
        if (r < I_GU) { const int nb = r % 176; const bool up = ((nb * 32) & 255) >= 128;
            transpose_item((up ? FIN(I_WFU) : FIN(I_WFG)) + (size_t)l * DM * DFF, DFF, DM, (h16*)(ws + WS_WGU), FIN(I_FNORM) + l * DM, scr, r, 176, F.lane, MapGU()); continue; } r -= I_GU;
        transpose_item(FIN(I_WFD) + (size_t)l * DFF * DM, DM, DFF, (h16*)(ws + WS_WDN), nullptr, scr, r, 32, F.lane, MapId());
    }
    const int gt = F.bid * NTHREADS + F.tid, NGT = F.G * NTHREADS;
    float* wiw = (float*)(ws + WS_SMALL + SM_WIW); float* lbv = (float*)(ws + WS_SMALL + SM_LB);
    for (int i = gt; i < DM * 8; i += NGT) { const int k = i >> 3, j = i & 7; wiw[i] = FIN(I_ANORM)[l * DM + k] * FIN(I_WIN)[(size_t)l * DM * IN_COLS + (size_t)k * IN_COLS + 1344 + j]; }
    for (int i = gt; i < 512; i += NGT) { const float* lg = FIN(I_LBLOG);
        const float v0 = lg[i], v1 = lg[512 + i], v2 = lg[1024 + i], v3 = lg[1536 + i]; const float mx = fmaxf(fmaxf(v0, v1), fmaxf(v2, v3));
        const float e0 = expf(v0 - mx), e1 = expf(v1 - mx), e2 = expf(v2 - mx), e3 = expf(v3 - mx), s = (e0 + e1) + (e2 + e3);
        float c = 0.f; if (l >= 1) c += e1 / s; if (l >= 2) c += e2 / s; if (l >= 3) c += e3 / s;
        lbv[i] = c; }
    if (l == 0) {
        const float* x = FIN(I_X); const int* pos = (const int*)FIN(I_POS);
        h16* x16 = (h16*)(ws + WS_X16); float* rsa = (float*)(ws + WS_RSA); float* cosT = (float*)(ws + WS_COS); float* sinT = (float*)(ws + WS_SIN);
        for (int m = gw; m < M; m += NGW) {
            const f32x4* xr = (const f32x4*)(x + (size_t)m * DM) + F.lane;
#pragma unroll
            for (int j = 0; j < 4; ++j) { const f32x4 v = xr[64 * j]; float ss = (v[0] * v[0] + v[1] * v[1]) + (v[2] * v[2] + v[3] * v[3]);
                u32x2 w; w.x = pkh(v[0], v[1]); w.y = pkh(v[2], v[3]); *((u32x2*)(x16 + (size_t)m * DM) + F.lane + 64 * j) = w;
                ss += __shfl_xor(ss, 1); ss += __shfl_xor(ss, 2); ss += __shfl_xor(ss, 4); ss += __shfl_xor(ss, 8);
                if ((F.lane & 15) == 0) rsa[(size_t)m * 16 + j * 4 + (F.lane >> 4)] = ss; }
            if (F.lane < 32) { const float inv_freq = exp2f(-(float)F.lane * (13.287712379549449f / 32.0f));
                const float ang = (float)pos[m] * inv_freq; float sn, cs; sincosf(ang, &sn, &cs); cosT[(size_t)m * 32 + F.lane] = cs; sinT[(size_t)m * 32 + F.lane] = sn; }
        }
    }
}

__device__ __forceinline__ void ph2_rows(Frame& F) {
    unsigned char* ws = F.ws;
    LAS float* wiw_s = (LAS float*)(F.lds);
    { const float* wiw = (const float*)(ws + WS_SMALL + SM_WIW); for (int i = F.tid; i < DM * 8; i += NTHREADS) wiw_s[i] = wiw[i]; }
    __syncthreads();
    const int gw = F.bid * NWAVES + F.wave, NGW = F.G * NWAVES;
    const h16* P = (const h16*)(ws + WS_P); const h16* x16 = (const h16*)(ws + WS_X16);
    const float* rsa = (const float*)(ws + WS_RSA); const float* cosT = (const float*)(ws + WS_COS); const float* sinT = (const float*)(ws + WS_SIN);
    float* rq = (float*)(ws + WS_SMALL + SM_RSTDQ); float* rkv = (float*)(ws + WS_SMALL + SM_RSTDKV); float* iw = (float*)(ws + WS_SMALL + SM_IW); h16* kpe = (h16*)(ws + WS_KPE);
    for (int m = gw; m < M; m += NGW) {
        const h16* pr = P + (size_t)m * NP;
        float sq = 0.f, skv = 0.f;
#pragma unroll
        for (int j = 0; j < 3; ++j) { const h16x2 v = *(const h16x2*)(pr + C_CQ + 2 * F.lane + 128 * j); const float a = (float)v.x, b = (float)v.y; sq += a * a + b * b; }
#pragma unroll
        for (int j = 0; j < 2; ++j) { const h16x2 v = *(const h16x2*)(pr + C_CKV + 2 * F.lane + 128 * j); const float a = (float)v.x, b = (float)v.y; skv += a * a + b * b; }
        sq = wave_sum(sq); skv = wave_sum(skv);
        float acc8[8] = {0.f, 0.f, 0.f, 0.f, 0.f, 0.f, 0.f, 0.f};
#pragma unroll 4
        for (int j = 0; j < 16; ++j) { const int k = j * 64 + F.lane; const float xv = (float)x16[(size_t)m * DM + k];
            const f32x4 w0 = *(const LAS f32x4*)(wiw_s + k * 8), w1 = *(const LAS f32x4*)(wiw_s + k * 8 + 4);
            acc8[0] += xv * w0[0]; acc8[1] += xv * w0[1]; acc8[2] += xv * w0[2]; acc8[3] += xv * w0[3];
            acc8[4] += xv * w1[0]; acc8[5] += xv * w1[1]; acc8[6] += xv * w1[2]; acc8[7] += xv * w1[3]; }
#pragma unroll
        for (int j = 0; j < 8; ++j) acc8[j] = wave_sum(acc8[j]);
        const float rsat = pg8::rstd_from_parts(rsa, m, 1.0f / 1024.0f);
        if (F.lane == 0) { rq[m] = __builtin_amdgcn_rsqf(sq * (1.0f / 384.0f) + EPS); rkv[m] = __builtin_amdgcn_rsqf(skv * (1.0f / 256.0f) + EPS); }
        if (F.lane < 8) { float v = acc8[0];
#pragma unroll
            for (int j = 1; j < 8; ++j) v = (F.lane == j) ? acc8[j] : v;
            iw[(size_t)m * 8 + F.lane] = v * rsat; }
        if (F.lane < 32) { const h16x2 v = *(const h16x2*)(pr + C_KPE + 2 * F.lane); const float a = (float)v.x, b = (float)v.y;
            const float cs = cosT[(size_t)m * 32 + F.lane], sn = sinT[(size_t)m * 32 + F.lane];
            *(unsigned*)(kpe + (size_t)m * 64 + 2 * F.lane) = pkh(a * cs - b * sn, b * cs + a * sn); }
    }
    __syncthreads();
}
__device__ __forceinline__ void hgrn_gate(float fr, float lb, float& lf, float& kin) {
    fr = fminf(fmaxf(fr, -30.f), 30.f); const float e = __expf(-fr), sg = 1.0f / (1.0f + e);
    const float f = fmaxf(lb + (1.0f - lb) * sg, 1e-30f);
    lf = __logf(f);
    kin = (1.0f - lb) * (e * sg);
}
__device__ __forceinline__ void hgrn_b1_unit(Frame& F, int b, int c) {
    unsigned char* ws = F.ws; const h16* P = (const h16*)(ws + WS_P);
    const float* lbv = (const float*)(ws + WS_SMALL + SM_LB); float* dc = (float*)(ws + WS_SMALL + SM_DC);
    unsigned short* ST = (unsigned short*)(ws + WS_ST);
    LAS unsigned char* khT = F.lds; LAS unsigned char* inT = F.lds + 65536;
    int col = F.tid; asm volatile("" : "+v"(col)); const size_t m0 = (size_t)b * SEQ + (size_t)c * 64;
    const float lb = lbv[col];
    const h16* pf = P + m0 * NP + C_BF + col; const h16* pi = P + m0 * NP + C_BI + col;
    float bL = 0.f;
    for (int s = 0; s < 64; ++s) { float lf, kin; hgrn_gate((float)pf[(size_t)s * NP], lb, lf, kin); bL += lf; }
    float bs = 0.f;
    for (int ch = 0; ch < 8; ++ch) { float kv[8], iv[8];
#pragma unroll
        for (int j = 0; j < 8; ++j) { const int s = ch * 8 + j; float lf, kin; hgrn_gate((float)pf[(size_t)s * NP], lb, lf, kin); bs += lf; kv[j] = kin * __expf(bL - bs); iv[j] = (float)pi[(size_t)s * NP]; }
        u32x4 wk, wi; wk.x = pkb(kv[0], kv[1]); wk.y = pkb(kv[2], kv[3]); wk.z = pkb(kv[4], kv[5]); wk.w = pkb(kv[6], kv[7]);
        wi.x = pkb(iv[0], iv[1]); wi.y = pkb(iv[2], iv[3]); wi.z = pkb(iv[4], iv[5]); wi.w = pkb(iv[6], iv[7]);
        const int pc = (ch ^ (col & 7)) * 16;
        *(LAS u32x4*)(khT + col * 128 + pc) = wk; *(LAS u32x4*)(inT + col * 128 + pc) = wi; }
    dc[(size_t)(b * 32 + c) * 512 + col] = __expf(bL);
    __syncthreads();
    const int h = F.wave >> 1, kh = F.wave & 1, r = col & 31, hh = (col >> 5) & 1;
    unsigned short* out = ST + ((size_t)((b * 4 + h) * 32 + c)) * 16384;
    for (int vt = 0; vt < 4; ++vt) {
        f32x16 acc0 = {}, acc1 = {};
        const int arow = h * 128 + vt * 32 + r, brow0 = h * 128 + (2 * kh) * 32 + r, brow1 = brow0 + 32;
#pragma unroll
        for (int sg = 0; sg < 4; ++sg) { const int ch = 2 * sg + hh;
            const bf16x8 a = *(const LAS bf16x8*)(inT + arow * 128 + ((ch ^ (arow & 7)) * 16));
            const bf16x8 b0 = *(const LAS bf16x8*)(khT + brow0 * 128 + ((ch ^ (brow0 & 7)) * 16));
            const bf16x8 b1 = *(const LAS bf16x8*)(khT + brow1 * 128 + ((ch ^ (brow1 & 7)) * 16));
            acc0 = __builtin_amdgcn_mfma_f32_32x32x16_bf16(a, b0, acc0, 0, 0, 0);
            acc1 = __builtin_amdgcn_mfma_f32_32x32x16_bf16(a, b1, acc1, 0, 0, 0); }
#pragma unroll
        for (int q = 0; q < 16; ++q) { const int v = vt * 32 + crow(q, hh);
            out[(size_t)v * 128 + (2 * kh) * 32 + r] = (unsigned short)(pkb(acc0[q], 0.f) & 0xffffu);
            out[(size_t)v * 128 + (2 * kh + 1) * 32 + r] = (unsigned short)(pkb(acc1[q], 0.f) & 0xffffu); }
    }
    __syncthreads();
}
__device__ __forceinline__ void hgrn_scan_unit(Frame& F, int j) {
    unsigned char* ws = F.ws; const float* dc = (const float*)(ws + WS_SMALL + SM_DC); unsigned short* ST = (unsigned short*)(ws + WS_ST);
    int tid_ = F.tid; asm volatile("" : "+v"(tid_));
    const int gid = j * NTHREADS + tid_, bh = gid >> 12, e = (gid & 4095) * 4, k = e & 127, b = bh >> 2, h = bh & 3;
    float s0 = 0.f, s1 = 0.f, s2 = 0.f, s3 = 0.f;
    for (int c = 0; c < 32; ++c) {
        unsigned short* p = ST + ((size_t)(bh * 32 + c)) * 16384 + e;
        const u32x2 u = *(const u32x2*)p; const f32x4 d = *(const f32x4*)(dc + (size_t)(b * 32 + c) * 512 + h * 128 + k);
        s0 = d[0] * s0 + __uint_as_float(u.x << 16); s1 = d[1] * s1 + __uint_as_float(u.x & 0xffff0000u);
        s2 = d[2] * s2 + __uint_as_float(u.y << 16); s3 = d[3] * s3 + __uint_as_float(u.y & 0xffff0000u);
        u32x2 w; w.x = pkb(s0, s1); w.y = pkb(s2, s3); *(u32x2*)p = w;
    }
}
__device__ __forceinline__ void hgrn_b3_unit(Frame& F, const Args& args, int b, int c, int l) {
    unsigned char* ws = F.ws; h16* P = (h16*)(ws + WS_P);
    const float* lbv = (const float*)(ws + WS_SMALL + SM_LB); const unsigned short* ST = (const unsigned short*)(ws + WS_ST);
    const float* gain = FIN(I_ONORM) + l * 128;
    LAS unsigned char* QT = F.lds;
    LAS unsigned char* KB = F.lds + 32768;
    LAS unsigned char* inT = F.lds + 65536;
    LAS float* red = (LAS float*)(F.lds + 98304);
    const size_t m0 = (size_t)b * SEQ + (size_t)c * 64;
    int tid_ = F.tid; asm volatile("" : "+v"(tid_));
    for (int hp = 0; hp < 2; ++hp) {
        if (tid_ < 256) {
            const int hl = tid_ >> 7, k = tid_ & 127, h = 2 * hp + hl; const float lb = lbv[h * 128 + k];
            const h16* pf = P + m0 * NP + C_BF + h * 128 + k; const h16* pq = P + m0 * NP + C_BQ + h * 128 + k;
            float bs = 0.f;
            for (int s = 0; s < 64; ++s) { float lf, kin; hgrn_gate((float)pf[(size_t)s * NP], lb, lf, kin); bs += lf;
                const float bc = fmaxf(bs, -85.f); const float qv = (float)pq[(size_t)s * NP] * 0.08838834764831845f * __expf(bc), kvv = kin * __expf(-bc);
                const int off = hl * 16384 + s * 256 + (((k >> 3) ^ (s & 15)) * 16) + (k & 7) * 2;
                *(LAS unsigned short*)(QT + off) = (unsigned short)(pkb(qv, 0.f) & 0xffffu); *(LAS unsigned short*)(KB + off) = (unsigned short)(pkb(kvv, 0.f) & 0xffffu); }
        } else {
            const int t2 = tid_ - 256, hl = t2 >> 7, v = t2 & 127, h = 2 * hp + hl;
            const h16* pi = P + m0 * NP + C_BI + h * 128 + v;
            for (int ch = 0; ch < 8; ++ch) { float iv[8];
#pragma unroll
                for (int j = 0; j < 8; ++j) iv[j] = (float)pi[(size_t)(ch * 8 + j) * NP];
                u32x4 wi; wi.x = pkb(iv[0], iv[1]); wi.y = pkb(iv[2], iv[3]); wi.z = pkb(iv[4], iv[5]); wi.w = pkb(iv[6], iv[7]);
                *(LAS u32x4*)(inT + (hl * 128 + v) * 128 + ((ch ^ (v & 7)) * 16)) = wi; }
        }
        __syncthreads();
        const int hl = F.wave >> 2, ti = (F.wave >> 1) & 1, vh = F.wave & 1, h = 2 * hp + hl, r = tid_ & 31, hh = (tid_ >> 5) & 1;
        f32x16 o0 = {}, o1 = {};
        const int trow = ti * 32 + r;
        const LAS unsigned char* qrow = QT + hl * 16384 + trow * 256;
        if (c > 0) {
            const unsigned short* Sp = ST + ((size_t)((b * 4 + h) * 32 + (c - 1))) * 16384;
#pragma unroll
            for (int ks = 0; ks < 8; ++ks) { const bf16x8 qb = *(const LAS bf16x8*)(qrow + (((2 * ks + hh) ^ (trow & 15)) * 16));
                const bf16x8 a0 = *(const bf16x8*)(Sp + (size_t)((2 * vh) * 32 + r) * 128 + 16 * ks + 8 * hh);
                const bf16x8 a1 = *(const bf16x8*)(Sp + (size_t)((2 * vh + 1) * 32 + r) * 128 + 16 * ks + 8 * hh);
                o0 = __builtin_amdgcn_mfma_f32_32x32x16_bf16(a0, qb, o0, 0, 0, 0);
                o1 = __builtin_amdgcn_mfma_f32_32x32x16_bf16(a1, qb, o1, 0, 0, 0); }
        }
        for (int sj = 0; sj <= ti; ++sj) {
            f32x16 at = {};
            const int srow = sj * 32 + r; const LAS unsigned char* krow = KB + hl * 16384 + srow * 256;
#pragma unroll
            for (int ks = 0; ks < 8; ++ks) { const bf16x8 qb = *(const LAS bf16x8*)(qrow + (((2 * ks + hh) ^ (trow & 15)) * 16));
                const bf16x8 ka = *(const LAS bf16x8*)(krow + (((2 * ks + hh) ^ (srow & 15)) * 16));
                at = __builtin_amdgcn_mfma_f32_32x32x16_bf16(ka, qb, at, 0, 0, 0); }
            if (sj == ti) {
#pragma unroll
                for (int q = 0; q < 16; ++q) if (crow(q, hh) > r) at[q] = 0.f; }
#pragma unroll
            for (int sg = 0; sg < 2; ++sg) {
                u32x4 pw; pw.x = pkb(at[8 * sg + 0], at[8 * sg + 1]); pw.y = pkb(at[8 * sg + 2], at[8 * sg + 3]); pw.z = pkb(at[8 * sg + 4], at[8 * sg + 5]); pw.w = pkb(at[8 * sg + 6], at[8 * sg + 7]);
                const bf16x8 pb = __builtin_bit_cast(bf16x8, pw);
                const int ch = 4 * sj + 2 * sg;
#pragma unroll
                for (int vt = 0; vt < 2; ++vt) { const int vrow = (2 * vh + vt) * 32 + r; const LAS unsigned char* ir = inT + (hl * 128 + vrow) * 128 + 8 * hh;
                    const u32x2 lo = *(const LAS u32x2*)(ir + ((ch ^ (vrow & 7)) * 16)), hi2 = *(const LAS u32x2*)(ir + (((ch + 1) ^ (vrow & 7)) * 16));
                    u32x4 aw; aw.x = lo.x; aw.y = lo.y; aw.z = hi2.x; aw.w = hi2.y;
                    if (vt == 0) o0 = __builtin_amdgcn_mfma_f32_32x32x16_bf16(__builtin_bit_cast(bf16x8, aw), pb, o0, 0, 0, 0);
                    else o1 = __builtin_amdgcn_mfma_f32_32x32x16_bf16(__builtin_bit_cast(bf16x8, aw), pb, o1, 0, 0, 0); }
            }
        }
        float ss = 0.f;
#pragma unroll
        for (int q = 0; q < 16; ++q) ss += o0[q] * o0[q] + o1[q] * o1[q];
        ss += __shfl_xor(ss, 32);
        if (hh == 0) red[F.wave * 32 + r] = ss;
        __syncthreads();
        const float tot = red[F.wave * 32 + r] + red[(F.wave ^ 1) * 32 + r];
        const float rs = __builtin_amdgcn_rsqf(tot * (1.0f / 128.0f) + EPS);
        const size_t m = m0 + trow; h16* orow = P + m * NP + C_OB + h * 128; const h16* grow = P + m * NP + C_BG + h * 128;
#pragma unroll
        for (int vt = 0; vt < 2; ++vt)
#pragma unroll
            for (int g4 = 0; g4 < 4; ++g4) { const int v0 = (2 * vh + vt) * 32 + 8 * g4 + 4 * hh;
                const h16x4 gv = *(const h16x4*)(grow + v0); const f32x4 gn = *(const f32x4*)(gain + v0); float y[4];
#pragma unroll
                for (int j = 0; j < 4; ++j) { const float ov = (vt == 0 ? o0[4 * g4 + j] : o1[4 * g4 + j]); const float g = (float)gv[j]; y[j] = ov * rs * gn[j] * (g * sigmoidf_(g)); }
                u32x2 w; w.x = pkh(y[0], y[1]); w.y = pkh(y[2], y[3]); *(u32x2*)(orow + v0) = w; }
        __syncthreads();
    }
}
__device__ __forceinline__ unsigned fkey(float v) { unsigned u = __float_as_uint(v); u = (u & 0x80000000u) ? ~u : (u | 0x80000000u); return (v == 0.0f) ? 0x80000000u : u; }
__device__ __forceinline__ void score_select_unit(Frame& F, int b, int g) {
    unsigned char* ws = F.ws; const h16* P = (const h16*)(ws + WS_P);
    unsigned long long* mask = (unsigned long long*)(ws + WS_MASK);
    const int t0 = 16 * g; const size_t mb = (size_t)b * SEQ;
    int lane_ = F.lane; asm volatile("" : "+v"(lane_));
    if (g < 16) {
        for (int q = 2 * F.wave; q < 2 * F.wave + 2; ++q) { const int t = t0 + q;
            if (F.lane < 32) { const int lo = 64 * F.lane; unsigned long long w;
                if (t >= lo + 63) w = ~0ull; else if (t < lo) w = 0ull; else w = (1ull << (t - lo + 1)) - 1ull;
                mask[(mb + t) * 32 + F.lane] = w; } }
        return;
    }
    LAS float* sc = (LAS float*)F.lds;
    LAS float* iw_s = (LAS float*)(F.lds + 131072);
    const float* iw = (const float*)(ws + WS_SMALL + SM_IW);
    if (F.tid < 128) iw_s[F.tid] = iw[(mb + t0) * 8 + F.tid];
    const int r = lane_ & 31, hh = lane_ >> 5;
    h16x8 aq[4][4];
#pragma unroll
    for (int rt = 0; rt < 4; ++rt)
#pragma unroll
        for (int ks = 0; ks < 4; ++ks) aq[rt][ks] = *(const h16x8*)(P + (mb + t0 + 4 * rt + (r >> 3)) * NP + C_IQ + (r & 7) * 64 + 16 * ks + 8 * hh);
    __syncthreads();
    const int nkb = (t0 + 16 + 31) >> 5;
    for (int kb = F.wave; kb < nkb; kb += 8) {
        h16x8 bk[4];
#pragma unroll
        for (int ks = 0; ks < 4; ++ks) bk[ks] = *(const h16x8*)(P + (mb + kb * 32 + r) * NP + C_IK + 16 * ks + 8 * hh);
#pragma unroll
        for (int rt = 0; rt < 4; ++rt) {
            f32x16 acc = {};
#pragma unroll
            for (int ks = 0; ks < 4; ++ks) acc = __builtin_amdgcn_mfma_f32_32x32x16_f16(aq[rt][ks], bk[ks], acc, 0, 0, 0);
#pragma unroll
            for (int qq = 0; qq < 4; ++qq) { const f32x4 w = *(const LAS f32x4*)(iw_s + (4 * rt + qq) * 8 + 4 * hh);
                float p = w[0] * fmaxf(acc[4 * qq + 0], 0.f) + w[1] * fmaxf(acc[4 * qq + 1], 0.f) + w[2] * fmaxf(acc[4 * qq + 2], 0.f) + w[3] * fmaxf(acc[4 * qq + 3], 0.f);
                p += __shfl_xor(p, 32);
                if (hh == 0) sc[(4 * rt + qq) * 2048 + kb * 32 + r] = p; }
        }
    }
    __syncthreads();
    for (int q = 2 * F.wave; q < 2 * F.wave + 2; ++q) {
        const int t = t0 + q;
        unsigned key[32];
#pragma unroll
        for (int j = 0; j < 32; ++j) { const int s = j * 64 + F.lane; const float v = sc[q * 2048 + s]; key[j] = (s <= t) ? fkey(v) : 0u; }
        unsigned T = 0u;
        for (int bit = 31; bit >= 0; --bit) { const unsigned cand = T | (1u << bit); int cnt = 0;
#pragma unroll
            for (int j = 0; j < 32; ++j) cnt += __builtin_popcountll(__ballot(key[j] >= cand));
            if (cnt >= 256) T = cand; }
        int cgt = 0, ceq = 0;
#pragma unroll
        for (int j = 0; j < 32; ++j) { cgt += __builtin_popcountll(__ballot(key[j] > T)); ceq += __builtin_popcountll(__ballot(key[j] == T)); }
        int need = 256 - cgt; const bool all_eq = (ceq <= need);
#pragma unroll
        for (int j = 0; j < 32; ++j) {
            const unsigned long long gt = __ballot(key[j] > T), eq = __ballot(key[j] == T); unsigned long long take;
            if (all_eq) take = eq;
            else { const int pc = __builtin_popcountll(eq);
                if (pc <= need) { take = eq; need -= pc; }
                else { unsigned long long mrem = eq; take = 0ull; for (int i = 0; i < need; ++i) { const unsigned long long low = mrem & (0ull - mrem); take |= low; mrem ^= low; } need = 0; } }
            if (F.lane == 0) mask[(mb + t) * 32 + j] = gt | take;
        }
    }
    __syncthreads();
}

template <int MODE>
__device__ __forceinline__ void attn_unit(Frame& F, const Args& args, int b, int hsel, int qb) {
    constexpr int DQK = MODE == 0 ? 192 : 128, NKS = DQK / 16, KROW = DQK * 2, KTILE = 64 * KROW, VTILE = 16384, NKC = DQK / 8;
    unsigned char* ws = F.ws; h16* P = (h16*)(ws + WS_P);
    const h16* QC = (const h16*)(ws + WS_QC); const h16* KVC = (const h16*)(ws + WS_KVC); const h16* KPE = (const h16*)(ws + WS_KPE);
    const unsigned* mask = (const unsigned*)(ws + WS_MASK); const int* pos = (const int*)FIN(I_POS);
    LAS unsigned char* Kl = F.lds;
    LAS unsigned char* Vl = F.lds + 2 * KTILE;
    LAS float* tabB = (LAS float*)(F.lds + 2 * KTILE + 2 * VTILE);
    LAS int* posk = (LAS int*)(F.lds + 2 * KTILE + 2 * VTILE + 2048);
    const size_t mb = (size_t)b * SEQ;
    int lane_ = F.lane; asm volatile("" : "+v"(lane_));
    const int r = lane_ & 31, hh = lane_ >> 5;
    const int head = MODE == 0 ? hsel : (F.wave >> 1);
    const int tq = MODE == 0 ? (qb * 256 + F.wave * 32 + r) : (qb * 64 + (F.wave & 1) * 32 + r);
    const int tq_hi = MODE == 0 ? (qb * 256 + F.wave * 32 + 31) : (qb * 64 + (F.wave & 1) * 32 + 31);
    const int nt = MODE == 0 ? (4 * qb + 4) : (qb + 1);
    constexpr float SCL = MODE == 0 ? 0.07216878364870322f : 0.08838834764831845f;
    constexpr float L2E = 1.4426950408889634f;
    if (MODE == 1) {
        if (F.tid < 128) { const int d = F.tid; int bk;
            if (d < 16) bk = d; else bk = 16 + (d >= 19) + (d >= 21) + (d >= 24) + (d >= 27) + (d >= 31) + (d >= 35) + (d >= 40) + (d >= 46) + (d >= 52) + (d >= 59) + (d >= 67) + (d >= 77) + (d >= 87) + (d >= 99) + (d >= 113);
            const float* rb = FIN(I_RELB) + bk * 4; tabB[d * 4 + 0] = rb[0]; tabB[d * 4 + 1] = rb[1]; tabB[d * 4 + 2] = rb[2]; tabB[d * 4 + 3] = rb[3]; }
    }
    h16x8 qf[NKS];
    { const h16* qp = MODE == 0 ? (QC + (mb + tq) * 768 + head * 192) : (P + (mb + tq) * NP + C_AQ + head * 128);
#pragma unroll
        for (int ks = 0; ks < NKS; ++ks) qf[ks] = *(const h16x8*)(qp + 16 * ks + 8 * hh); }
    const int posq = MODE == 1 ? pos[mb + tq] : 0;
    int tid_ = F.tid; asm volatile("" : "+v"(tid_));
    const int skey = tid_ >> 3, sc8 = tid_ & 7;
    u32x4 stK[NKC / 8], stV[2]; int stPos = 0;
    auto load_tile = [&](int kt) {
        const size_t km = mb + (size_t)kt * 64 + skey;
        if (MODE == 0) { const h16* kn = KVC + km * 1024 + head * 256;
            stK[0] = *(const u32x4*)(kn + 8 * sc8); stK[1] = *(const u32x4*)(kn + 64 + 8 * sc8); stK[2] = *(const u32x4*)(KPE + km * 64 + 8 * sc8);
            stV[0] = *(const u32x4*)(kn + 128 + 8 * sc8); stV[1] = *(const u32x4*)(kn + 192 + 8 * sc8); }
        else { const h16* kp = P + km * NP;
            stK[0] = *(const u32x4*)(kp + C_AK + 8 * sc8); stK[1] = *(const u32x4*)(kp + C_AK + 64 + 8 * sc8);
            stV[0] = *(const u32x4*)(kp + C_AV + 8 * sc8); stV[1] = *(const u32x4*)(kp + C_AV + 64 + 8 * sc8);
            if (sc8 == 0) stPos = pos[km]; }
    };
    auto store_tile = [&](int buf) {
        LAS unsigned char* kd = Kl + buf * KTILE + skey * KROW;
#pragma unroll
        for (int i = 0; i < NKC / 8; ++i) { const int c = sc8 + 8 * i; *(LAS u32x4*)(kd + ((c ^ (skey & 7)) * 16)) = stK[i]; }
        LAS unsigned char* vd = Vl + buf * VTILE;
#pragma unroll
        for (int i = 0; i < 2; ++i) { const int d0 = 8 * sc8 + 64 * i; const unsigned wv[4] = {stV[i].x, stV[i].y, stV[i].z, stV[i].w};
#pragma unroll
            for (int j = 0; j < 8; ++j) { const int d = d0 + j; const unsigned short e = (unsigned short)((wv[j >> 1] >> ((j & 1) * 16)) & 0xffffu);
                *(LAS unsigned short*)(vd + d * 128 + (((skey >> 3) ^ (d & 7)) * 16) + (skey & 7) * 2) = e; } }
        if (MODE == 1 && sc8 == 0) posk[buf * 64 + skey] = stPos;
    };
    float m_run = -1e30f, l_run = 0.f;
    f32x16 o[4]; o[0] = f32x16{}; o[1] = f32x16{}; o[2] = f32x16{}; o[3] = f32x16{};
    load_tile(0); store_tile(0);
    __syncthreads();
    const int nt_w = (tq_hi >> 6) + 1;
    for (int kt = 0; kt < nt_w; ++kt) {
        const int buf = kt & 1;
        if (kt + 1 < nt) load_tile(kt + 1);
        {
            f32x16 s0 = {}, s1 = {};
            const LAS unsigned char* kr0 = Kl + buf * KTILE + r * KROW;
            const LAS unsigned char* kbs[4] = {kr0 + ((0 + hh) ^ (r & 7)) * 16, kr0 + ((2 + hh) ^ (r & 7)) * 16, kr0 + ((4 + hh) ^ (r & 7)) * 16, kr0 + ((6 + hh) ^ (r & 7)) * 16};
            constexpr int NG = NKS / 2;
            h16x8 kf[2][4];
#define LDKG(g, dst) do { _Pragma("unroll") for (int i_ = 0; i_ < 2; ++i_) { const int ks_ = 2 * (g) + i_; \
                dst[2 * i_] = *(const LAS h16x8*)(kbs[ks_ & 3] + (ks_ >> 2) * 128); dst[2 * i_ + 1] = *(const LAS h16x8*)(kbs[ks_ & 3] + (ks_ >> 2) * 128 + 32 * KROW); } } while (0)
            LDKG(0, kf[0]);
#pragma unroll
            for (int g = 0; g < NG; ++g) {
                if (g + 1 < NG) LDKG(g + 1, kf[(g + 1) & 1]);
#pragma unroll
                for (int i = 0; i < 2; ++i) { s0 = __builtin_amdgcn_mfma_f32_32x32x16_f16(kf[g & 1][2 * i], qf[2 * g + i], s0, 0, 0, 0);
                    s1 = __builtin_amdgcn_mfma_f32_32x32x16_f16(kf[g & 1][2 * i + 1], qf[2 * g + i], s1, 0, 0, 0); }
                __builtin_amdgcn_sched_barrier(0);
            }
#undef LDKG
            const float NEG = -__builtin_inff();
            if (MODE == 0) {
                const int kbase = 64 * kt + 4 * hh;
#pragma unroll
                for (int q = 0; q < 16; ++q) { const int kk = kbase + (q & 3) + 8 * (q >> 2);
                    s0[q] = (kk > tq) ? NEG : s0[q] * (SCL * L2E); s1[q] = (kk + 32 > tq) ? NEG : s1[q] * (SCL * L2E); }
            } else {
                const u32x2 mw = *(const u32x2*)(mask + (mb + tq) * 64 + 2 * kt);
#pragma unroll
                for (int q = 0; q < 16; ++q) { const int kl = crow(q, hh);
                    int d0 = posq - posk[buf * 64 + kl]; d0 = d0 < 0 ? 0 : (d0 > 127 ? 127 : d0);
                    int d1 = posq - posk[buf * 64 + 32 + kl]; d1 = d1 < 0 ? 0 : (d1 > 127 ? 127 : d1);
                    const float b0 = tabB[d0 * 4 + head], b1 = tabB[d1 * 4 + head];
                    s0[q] = ((mw.x >> kl) & 1u) ? (s0[q] * SCL + b0) * L2E : NEG;
                    s1[q] = ((mw.y >> kl) & 1u) ? (s1[q] * SCL + b1) * L2E : NEG; }
            }
            float pmax = s0[0];
#pragma unroll
            for (int q = 1; q < 16; ++q) pmax = fmaxf(pmax, s0[q]);
#pragma unroll
            for (int q = 0; q < 16; ++q) pmax = fmaxf(pmax, s1[q]);
            pmax = fmaxf(pmax, __shfl_xor(pmax, 32));
            const float m_new = fmaxf(m_run, pmax);
            const float alpha = __builtin_amdgcn_exp2f(m_run - m_new);
            m_run = m_new;
            float ps = 0.f;
#pragma unroll
            for (int q = 0; q < 16; ++q) { s0[q] = __builtin_amdgcn_exp2f(s0[q] - m_new); s1[q] = __builtin_amdgcn_exp2f(s1[q] - m_new); ps += s0[q] + s1[q]; }
            ps += __shfl_xor(ps, 32);
            l_run = l_run * alpha + ps;
#pragma unroll
            for (int dt = 0; dt < 4; ++dt)
#pragma unroll
                for (int q = 0; q < 16; ++q) o[dt][q] *= alpha;
            __builtin_amdgcn_sched_barrier(0);
            const LAS unsigned char* vb = Vl + buf * VTILE + 8 * hh + r * 128;
            const LAS unsigned char* vbs[8];
#pragma unroll
            for (int cc = 0; cc < 8; ++cc) vbs[cc] = vb + ((cc ^ (r & 7)) * 16);
#pragma unroll
            for (int kbk = 0; kbk < 2; ++kbk)
#pragma unroll
                for (int sg = 0; sg < 2; ++sg) {
                    u32x4 pw;
                    if (kbk == 0) { pw.x = pkh(s0[8 * sg + 0], s0[8 * sg + 1]); pw.y = pkh(s0[8 * sg + 2], s0[8 * sg + 3]); pw.z = pkh(s0[8 * sg + 4], s0[8 * sg + 5]); pw.w = pkh(s0[8 * sg + 6], s0[8 * sg + 7]); }
                    else { pw.x = pkh(s1[8 * sg + 0], s1[8 * sg + 1]); pw.y = pkh(s1[8 * sg + 2], s1[8 * sg + 3]); pw.z = pkh(s1[8 * sg + 4], s1[8 * sg + 5]); pw.w = pkh(s1[8 * sg + 6], s1[8 * sg + 7]); }
                    const h16x8 pb = __builtin_bit_cast(h16x8, pw);
                    const int ch = 4 * kbk + 2 * sg;
#pragma unroll
                    for (int dt = 0; dt < 4; ++dt) {
                        const u32x2 lo = *(const LAS u32x2*)(vbs[ch] + dt * 4096), hi2 = *(const LAS u32x2*)(vbs[ch + 1] + dt * 4096);
                        u32x4 aw; aw.x = lo.x; aw.y = lo.y; aw.z = hi2.x; aw.w = hi2.y;
                        o[dt] = __builtin_amdgcn_mfma_f32_32x32x16_f16(__builtin_bit_cast(h16x8, aw), pb, o[dt], 0, 0, 0); }
                    __builtin_amdgcn_sched_barrier(0);
                }
        }
        if (kt + 1 < nt) store_tile(buf ^ 1);
        __syncthreads();
    }
    for (int kt = nt_w; kt < nt; ++kt) {
        if (kt + 1 < nt) { load_tile(kt + 1); store_tile((kt & 1) ^ 1); }
        __syncthreads();
    }
    const float rl = 1.0f / l_run;
    h16* op = P + (mb + tq) * NP + (MODE == 0 ? C_OC : C_OA) + head * 128;
#pragma unroll
    for (int dt = 0; dt < 4; ++dt)
#pragma unroll
        for (int g4 = 0; g4 < 4; ++g4) { const int d0 = 32 * dt + 8 * g4 + 4 * hh;
            u32x2 w; w.x = pkh(o[dt][4 * g4 + 0] * rl, o[dt][4 * g4 + 1] * rl); w.y = pkh(o[dt][4 * g4 + 2] * rl, o[dt][4 * g4 + 3] * rl);
            *(u32x2*)(op + d0) = w; }
    __syncthreads();
}
#ifndef MK_SINGLE
#define MK_SINGLE 1
#endif
#define PHEN(k) ((KMASK >> (k)) & 1)
constexpr int PH_PER_LAYER = 9, PH_FINAL = NL * PH_PER_LAYER, PH_COUNT = PH_FINAL + 1;

__device__ __forceinline__ Frame phase_frame(const Frame& F) {
    Frame P = F; unsigned z = 0u; asm volatile("" : "+v"(z)); const int ln = (int)__builtin_amdgcn_mbcnt_hi(~0u, __builtin_amdgcn_mbcnt_lo(~0u, z)); P.lane = ln; P.tid = F.wave * 64 + ln;
    unsigned long long w = (unsigned long long)F.ws; asm volatile("" : "+s"(w)); P.ws = (unsigned char*)w; return P; }
template <int KMASK> __global__ void __launch_bounds__(NTHREADS, 2) mk_fwd(Args args) {
    extern __shared__ __attribute__((aligned(16))) unsigned char lds_raw[];
    Frame F;
    F.lds = (LAS unsigned char*)lds_raw;
    F.tid = threadIdx.x; F.lane = F.tid & 63; F.wave = __builtin_amdgcn_readfirstlane(F.tid >> 6);
    F.G = gridDim.x; F.bid = blockIdx.x; F.ws = args.ws; F.out = args.out;
    volatile LAS unsigned* MISC = (volatile LAS unsigned*)(F.lds + LDS_MISC);
    for (int u = F.tid; u < 256; u += NTHREADS) MISC[u] = 0u;
    __syncthreads();
    const int lo = args.ph_lo, hi = args.ph_hi;
    XcdBarrier bar; bar.bar = (unsigned*)(F.ws + WS_CTL) + 4096; bar.x = 0; bar.st = nullptr;
    if (hi - lo > 1) bar = xcd_barrier_post((unsigned*)(F.ws + WS_CTL) + 4096, MISC + 8);
#define IN(k) (lo <= (k) && (k) < hi)
#define SEAM(k) do { if ((k) + 1 < hi) xcd_barrier_call(bar.bar, bar.x, bar.st, F.wave); } while (0)
    for (int l = 0; l < NL; ++l) {
        const int p0 = l * PH_PER_LAYER;
        if (PHEN(0) && IN(p0 + 0)) { Frame Fp = phase_frame(F); unsigned char* ws = Fp.ws; asm volatile("; PHASE_MARK 0"); ph0_convert(Fp, args, l); SEAM(p0 + 0); }
        if (PHEN(1) && IN(p0 + 1)) { Frame Fp = phase_frame(F); unsigned char* ws = Fp.ws; asm volatile("; PHASE_MARK 1");
            pg8::PlainSched S; S.T.init(M, NP, Fp.G, Fp.bid); S.A = (const char*)(ws + WS_X16); S.B = (const char*)(ws + WS_WIN); S.lda2 = DM * 2; S.ldb2 = DM * 2;
            pg8::EpiScaleParts E{(h16*)(ws + WS_P), NP, (const float*)(ws + WS_RSA)};
            pg8::gemm_phase(Fp.lds, Fp.tid, DM, S.lda2, S.ldb2, S, E);
            SEAM(p0 + 1);
        }
        if (PHEN(2) && IN(p0 + 2)) { Frame Fp = phase_frame(F); unsigned char* ws = Fp.ws; asm volatile("; PHASE_MARK 2");
            for (int u = Fp.bid; u < NB * 32; u += Fp.G) hgrn_b1_unit(Fp, u >> 5, u & 31);
            ph2_rows(Fp);
            SEAM(p0 + 2);
        }
        if (PHEN(3) && IN(p0 + 3)) { Frame Fp = phase_frame(F); unsigned char* ws = Fp.ws; asm volatile("; PHASE_MARK 3");
            { pg8::PlainSched S; S.T.init(M, 768, Fp.G, Fp.bid); S.A = (const char*)(ws + WS_P) + C_CQ * 2; S.B = (const char*)(ws + WS_WQB); S.lda2 = NP * 2; S.ldb2 = 384 * 2;
              pg8::EpiScaleRow<true> E{(h16*)(ws + WS_QC), 768, (const float*)(ws + WS_SMALL + SM_RSTDQ), (const float*)(ws + WS_COS), (const float*)(ws + WS_SIN)};
              pg8::gemm_phase(Fp.lds, Fp.tid, 384, S.lda2, S.ldb2, S, E); }
        }
        if (PHEN(11) && IN(p0 + 3)) { Frame Fp = phase_frame(F); unsigned char* ws = Fp.ws; asm volatile("; PHASE_MARK 11");
            { pg8::PlainSched S; S.T.init(M, 1024, Fp.G, Fp.bid); S.A = (const char*)(ws + WS_P) + C_CKV * 2; S.B = (const char*)(ws + WS_WKVB); S.lda2 = NP * 2; S.ldb2 = 256 * 2;
              pg8::EpiScaleRow<false> E{(h16*)(ws + WS_KVC), 1024, (const float*)(ws + WS_SMALL + SM_RSTDKV), nullptr, nullptr};
              pg8::gemm_phase(Fp.lds, Fp.tid, 256, S.lda2, S.ldb2, S, E); }
        }
        if (PHEN(10) && IN(p0 + 3)) { Frame Fp = phase_frame(F); unsigned char* ws = Fp.ws; asm volatile("; PHASE_MARK 10");
            for (int u = Fp.bid; u < NB * 128; u += Fp.G) { const int j = u >> 8, i = u & 255, gi = i >> 3; const int g = j * 32 + ((j & 1) ? (31 - gi) : gi); score_select_unit(Fp, i & 7, g); }
            for (int u = Fp.bid; u < 256; u += Fp.G) hgrn_scan_unit(Fp, u);
        }
        if ((PHEN(3) || PHEN(10) || PHEN(11)) && IN(p0 + 3)) { SEAM(p0 + 3); }
        if (PHEN(4) && IN(p0 + 4)) { Frame Fp = phase_frame(F); unsigned char* ws = Fp.ws; asm volatile("; PHASE_MARK 4");
            for (int u = Fp.bid; u < 256; u += Fp.G) attn_unit<0>(Fp, args, (u & 31) >> 2, u & 3, 7 - (u >> 5));
            for (int u = Fp.bid; u < 256; u += Fp.G) { const int v = 255 - u; attn_unit<1>(Fp, args, v & 7, 0, 31 - (v >> 3)); }
            for (int u = Fp.bid; u < 256; u += Fp.G) hgrn_b3_unit(Fp, args, u >> 5, u & 31, l);
            SEAM(p0 + 4);
        }
        if (PHEN(5) && IN(p0 + 5)) { Frame Fp = phase_frame(F); unsigned char* ws = Fp.ws; asm volatile("; PHASE_MARK 5");
            pg8::BranchSched S; S.T.init(M, DM, Fp.G, Fp.bid, 3); S.A = (const char*)(ws + WS_P); S.B = (const char*)(ws + WS_WUP); S.lda2 = NP * 2; S.ldb2 = 512 * 2;
            S.b_stride = (size_t)1024 * 512 * 2;
            pg8::EpiGateAcc E{(h16*)(ws + WS_MIX), (const h16*)(ws + WS_P) + C_G, NP};
            pg8::gemm_phase(Fp.lds, Fp.tid, 512, S.lda2, S.ldb2, S, E);
            SEAM(p0 + 5);
        }
        if (PHEN(6) && IN(p0 + 6)) { Frame Fp = phase_frame(F); unsigned char* ws = Fp.ws; asm volatile("; PHASE_MARK 6");
            pg8::PlainSched S; S.T.init(M, DM, Fp.G, Fp.bid); S.A = (const char*)(ws + WS_MIX); S.B = (const char*)(ws + WS_WOUT); S.lda2 = DM * 2; S.ldb2 = DM * 2;
            pg8::EpiResidual E{l == 0 ? FIN(I_X) : (const float*)Fp.out, Fp.out, (h16*)(ws + WS_X16), (float*)(ws + WS_RSF)};
            pg8::gemm_phase(Fp.lds, Fp.tid, DM, S.lda2, S.ldb2, S, E);
            SEAM(p0 + 6);
        }
        if (PHEN(7) && IN(p0 + 7)) { Frame Fp = phase_frame(F); unsigned char* ws = Fp.ws; asm volatile("; PHASE_MARK 7");
            pg8::PlainSched S; S.T.init(M, 2 * DFF, Fp.G, Fp.bid); S.A = (const char*)(ws + WS_X16); S.B = (const char*)(ws + WS_WGU); S.lda2 = DM * 2; S.ldb2 = DM * 2;
            pg8::EpiSwiGLU E{(h16*)(ws + WS_ACT), (const float*)(ws + WS_RSF)};
            pg8::gemm_phase(Fp.lds, Fp.tid, DM, S.lda2, S.ldb2, S, E);
            SEAM(p0 + 7);
        }
        if (PHEN(8) && IN(p0 + 8)) { Frame Fp = phase_frame(F); unsigned char* ws = Fp.ws; asm volatile("; PHASE_MARK 8");
            pg8::PlainSched S; S.T.init(M, DM, Fp.G, Fp.bid); S.A = (const char*)(ws + WS_ACT); S.B = (const char*)(ws + WS_WDN); S.lda2 = DFF * 2; S.ldb2 = DFF * 2;
            pg8::EpiResidual E{(const float*)Fp.out, Fp.out, (h16*)(ws + WS_X16), (float*)(ws + WS_RSA)};
            pg8::gemm_phase(Fp.lds, Fp.tid, DFF, S.lda2, S.ldb2, S, E);
            SEAM(p0 + 8);
        }
    }
    if (PHEN(9) && IN(PH_FINAL)) { Frame Fp = phase_frame(F); unsigned char* ws = Fp.ws; asm volatile("; PHASE_MARK 9");
        const int gw = Fp.bid * NWAVES + Fp.wave, NGW = Fp.G * NWAVES; const f32x4* gn = (const f32x4*)FIN(I_FINAL);
        for (int m = gw; m < M; m += NGW) { f32x4* xr = (f32x4*)(Fp.out + (size_t)m * DM) + Fp.lane; f32x4 v[4]; float ss = 0.f;
#pragma unroll
            for (int j = 0; j < 4; ++j) { v[j] = xr[64 * j]; ss += (v[j][0] * v[j][0] + v[j][1] * v[j][1]) + (v[j][2] * v[j][2] + v[j][3] * v[j][3]); }
            const float rs = 1.0f / sqrtf(wave_sum(ss) * (1.0f / DM) + EPS);
#pragma unroll
            for (int j = 0; j < 4; ++j) xr[64 * j] = v[j] * rs * gn[Fp.lane + 64 * j]; }
    }
#undef IN
#undef SEAM
}

extern "C" void kernel_launch(void* const* d_in, const int* in_sizes, int n_in, void* d_out, int out_size, void* d_ws, size_t ws_size, hipStream_t stream) {
    static int grid = 0;
    if (grid == 0) {
        if (n_in != 20 || out_size != M * DM || ws_size < WS_END) { fprintf(stderr, "kernel_launch: unexpected shapes (n_in %d out %d ws %zu need %zu)\n", n_in, out_size, ws_size, (size_t)WS_END); grid = -1; return; }
        int dev = 0, cus = 0, per_cu = 0;
        if (hipGetDevice(&dev) != hipSuccess || hipDeviceGetAttribute(&cus, hipDeviceAttributeMultiprocessorCount, dev) != hipSuccess) { grid = -1; return; }
#if MK_SINGLE
        if (hipFuncSetAttribute((const void*)mk_fwd<0xfff>, hipFuncAttributeMaxDynamicSharedMemorySize, LDS_BYTES) != hipSuccess) { fprintf(stderr, "kernel_launch: hipFuncSetAttribute failed\n"); grid = -1; return; }
        if (hipOccupancyMaxActiveBlocksPerMultiprocessor(&per_cu, (const void*)mk_fwd<0xfff>, NTHREADS, LDS_BYTES) != hipSuccess || per_cu < 1) { fprintf(stderr, "kernel_launch: occupancy query says %d\n", per_cu); grid = -1; return; }
#else
        { const void* fns[12] = {(const void*)mk_fwd<1024>, (const void*)mk_fwd<2048>, (const void*)mk_fwd<1>, (const void*)mk_fwd<2>, (const void*)mk_fwd<4>, (const void*)mk_fwd<8>, (const void*)mk_fwd<16>, (const void*)mk_fwd<32>, (const void*)mk_fwd<64>, (const void*)mk_fwd<128>, (const void*)mk_fwd<256>, (const void*)mk_fwd<512>};
          for (int i = 0; i < 12; ++i) if (hipFuncSetAttribute(fns[i], hipFuncAttributeMaxDynamicSharedMemorySize, LDS_BYTES) != hipSuccess) { fprintf(stderr, "kernel_launch: hipFuncSetAttribute failed\n"); grid = -1; return; } }
        (void)per_cu;
#endif
        (void)hipGetLastError();
        grid = cus;
    }
    if (grid < 0) return;
    (void)hipMemsetAsync((char*)d_ws + WS_CTL, 0, CTL_BYTES, stream);
    Args a{};
    for (int i = 0; i < 20; ++i) a.in[i] = (const float*)d_in[i];
    a.out = (float*)d_out; a.ws = (unsigned char*)d_ws;
#if MK_SINGLE
    a.ph_lo = 0; a.ph_hi = PH_COUNT;
    hipLaunchKernelGGL(mk_fwd<0xfff>, dim3(grid), dim3(NTHREADS), LDS_BYTES, stream, a);
#else
    for (int p = 0; p < PH_COUNT; ++p) { a.ph_lo = p; a.ph_hi = p + 1; const int k = (p == PH_FINAL) ? 9 : (p % PH_PER_LAYER);
        switch (k) {
            case 0: hipLaunchKernelGGL(mk_fwd<1>, dim3(grid), dim3(NTHREADS), LDS_BYTES, stream, a); break;
            case 1: hipLaunchKernelGGL(mk_fwd<2>, dim3(grid), dim3(NTHREADS), LDS_BYTES, stream, a); break;
            case 2: hipLaunchKernelGGL(mk_fwd<4>, dim3(grid), dim3(NTHREADS), LDS_BYTES, stream, a); break;
            case 3: hipLaunchKernelGGL(mk_fwd<8>, dim3(grid), dim3(NTHREADS), LDS_BYTES, stream, a); hipLaunchKernelGGL(mk_fwd<2048>, dim3(grid), dim3(NTHREADS), LDS_BYTES, stream, a); hipLaunchKernelGGL(mk_fwd<1024>, dim3(grid), dim3(NTHREADS), LDS_BYTES, stream, a); break;
            case 4: hipLaunchKernelGGL(mk_fwd<16>, dim3(grid), dim3(NTHREADS), LDS_BYTES, stream, a); break;
            case 5: hipLaunchKernelGGL(mk_fwd<32>, dim3(grid), dim3(NTHREADS), LDS_BYTES, stream, a); break;
            case 6: hipLaunchKernelGGL(mk_fwd<64>, dim3(grid), dim3(NTHREADS), LDS_BYTES, stream, a); break;
            case 7: hipLaunchKernelGGL(mk_fwd<128>, dim3(grid), dim3(NTHREADS), LDS_BYTES, stream, a); break;
            case 8: hipLaunchKernelGGL(mk_fwd<256>, dim3(grid), dim3(NTHREADS), LDS_BYTES, stream, a); break;
            default: hipLaunchKernelGGL(mk_fwd<512>, dim3(grid), dim3(NTHREADS), LDS_BYTES, stream, a); break;
        } }
#endif
}
```

```cpp
#include <hip/hip_runtime.h>
#include <cstdio>
#include <cstdint>

#define LAS __attribute__((address_space(3)))
typedef _Float16 h16;
typedef _Float16 h16x8 __attribute__((ext_vector_type(8)));
typedef _Float16 h16x4 __attribute__((ext_vector_type(4)));
typedef _Float16 h16x2 __attribute__((ext_vector_type(2)));
typedef short bf16x8 __attribute__((ext_vector_type(8)));
typedef short s16x4 __attribute__((ext_vector_type(4)));
typedef float f32x2 __attribute__((ext_vector_type(2)));
typedef float f32x4 __attribute__((ext_vector_type(4)));
typedef float f32x16 __attribute__((ext_vector_type(16)));
typedef unsigned u32x2 __attribute__((ext_vector_type(2)));
typedef unsigned u32x4 __attribute__((ext_vector_type(4)));

constexpr int NB = 8, SEQ = 2048, M = NB * SEQ, DM = 1024, NL = 4, NP = 5632, NPROJ = 7168, DFF = 2816, IN_COLS = 7176;
constexpr int NTHREADS = 512, NWAVES = 8;
constexpr float EPS = 1e-6f;
constexpr int C_AQ = 0, C_AK = 512, C_AV = 640, C_IQ = 768, C_BG = 1280, C_CQ = 1792, C_IK = 2176, C_KPE = 2240, C_CKV = 2304, C_G = 2560;
constexpr int C_OA = C_AQ, C_OB = C_BG, C_OC = C_CQ;
constexpr int HT_Q = 0, HT_F = 1, HT_I = 2;

constexpr size_t MiB = 1u << 20;
constexpr size_t WS_CTL = 0, CTL_BYTES = 1 * MiB;
constexpr size_t WS_WIN = 1 * MiB;
constexpr size_t WS_WUP = WS_WIN + 14 * MiB;
constexpr size_t WS_WOUT = WS_WUP + 3 * MiB;
constexpr size_t WS_WQB = WS_WOUT + 2 * MiB;
constexpr size_t WS_WKVB = WS_WQB + 1 * MiB;
constexpr size_t WS_WGU = WS_WKVB + 1 * MiB;
constexpr size_t WS_WDN = WS_WGU + 11 * MiB;
constexpr size_t WS_SMALL = WS_WDN + 6 * MiB;
constexpr size_t WS_RSA = WS_SMALL + 2 * MiB;
constexpr size_t WS_RSF = WS_RSA + 1 * MiB;
constexpr size_t WS_COS = WS_RSF + 1 * MiB;
constexpr size_t WS_SIN = WS_COS + 2 * MiB;
constexpr size_t WS_KPE = WS_SIN + 2 * MiB;
constexpr size_t WS_MASK = WS_KPE + 2 * MiB;
constexpr size_t WS_X16 = WS_MASK + 4 * MiB;
constexpr size_t WS_QC = WS_X16 + 32 * MiB;
constexpr size_t WS_KN = WS_QC + 24 * MiB;
constexpr size_t WS_VCT = WS_KN + 16 * MiB;
constexpr size_t WS_MIX = WS_QC;
constexpr size_t WS_ST = WS_VCT + 16 * MiB;
constexpr size_t WS_HT = WS_ST + 32 * MiB;
constexpr size_t WS_AVT = WS_HT + 48 * MiB;
constexpr size_t WS_P = WS_AVT + 4 * MiB;
constexpr size_t WS_ACT = WS_P;
constexpr size_t WS_WDN2 = WS_P + 176 * MiB;
constexpr size_t WS_IKC = WS_WDN2 + 6 * MiB;
constexpr size_t WS_XLO = WS_IKC + 2 * MiB;
constexpr size_t WS_END = WS_XLO + 32 * MiB;
static_assert(WS_END <= 446 * MiB, "workspace map");
constexpr size_t SM_WIW = 0, SM_LB = 32768, SM_RSTDQ = 65536, SM_RSTDKV = 131072, SM_IW = 196608, SM_DC = 786432, SM_PMIN = 1572864, SM_PMAX = 1576960;

constexpr int LDS_MISC = 151552;
constexpr int LDS_BYTES = LDS_MISC + 1024;

#define VM_WAIT() asm volatile("s_waitcnt vmcnt(0)" ::: "memory")
#define LDS_WAIT() asm volatile("s_waitcnt lgkmcnt(0)" ::: "memory")

__device__ __forceinline__ unsigned pkh(float lo, float hi) { h16x2 v; v.x = (h16)lo; v.y = (h16)hi; return __builtin_bit_cast(unsigned, v); }
typedef float f32x2_t __attribute__((ext_vector_type(2)));
__device__ __forceinline__ u32x2 split_hl(float a, float b) { h16x2 h; h.x = (h16)a; h.y = (h16)b; const h16 hx = h.x, hy = h.y; u32x2 r; r.x = __builtin_bit_cast(unsigned, h); r.y = pkh(a - (float)hx, b - (float)hy); return r; }
__device__ __forceinline__ f32x2_t join_hl(unsigned hi, unsigned lo) { const h16x2 h = __builtin_bit_cast(h16x2, hi), l2 = __builtin_bit_cast(h16x2, lo); const h16 hx = h.x, hy = h.y, lx = l2.x, ly = l2.y; f32x2_t r; r.x = (float)hx + (float)lx; r.y = (float)hy + (float)ly; return r; }
__device__ __forceinline__ unsigned pkb(float lo, float hi) { unsigned r; asm volatile("v_cvt_pk_bf16_f32 %0, %1, %2" : "=v"(r) : "v"(lo), "v"(hi)); return r; }
__device__ __forceinline__ float bf2f(unsigned short b) { return __uint_as_float(((unsigned)b) << 16); }
__device__ __forceinline__ float wave_sum(float v) {
#pragma unroll
    for (int o = 1; o < 64; o <<= 1) v += __shfl_xor(v, o);
    return v;
}
__device__ __forceinline__ float sigmoidf_(float x) { return __builtin_amdgcn_rcpf(1.0f + __builtin_amdgcn_exp2f(-1.4426950408889634f * x)); }
__device__ __forceinline__ int crow(int r, int hi) { return (r & 3) + 8 * (r >> 2) + 4 * hi; }

#define XB_TMO      128
#define XB_XCNT(j)  (256  + 64 * (j))
#define XB_XSUB(j)  (1280 + 64 * (j))
#define XB_XGEN(j)  (2304 + 64 * (j))
#define XB_TOP      3328
#define XB_TOPGEN   3392
#define XCD_BAR_WORDS 3456
#define XB_SPIN_CAP (1u << 18)
__device__ __forceinline__ unsigned xb_ld(unsigned* p)              { return __hip_atomic_load(p, __ATOMIC_RELAXED, __HIP_MEMORY_SCOPE_AGENT); }
__device__ __forceinline__ unsigned xb_add(unsigned* p, unsigned v) { return __hip_atomic_fetch_add(p, v, __ATOMIC_RELAXED, __HIP_MEMORY_SCOPE_AGENT); }
__device__ __forceinline__ unsigned xb_xcc_id() { return (unsigned)__builtin_amdgcn_s_getreg((3 << 11) | 20) & 0xFu; }
#define XB_SPIN(cond, bar) do { unsigned _sp = 0; while (cond) { __builtin_amdgcn_s_sleep(1); \
    if ((++_sp & 255u) == 0u) { if (xb_ld(&(bar)[XB_TMO])) break; if (_sp > XB_SPIN_CAP) { atomicAdd(&(bar)[XB_TMO], 1u); break; } } } } while (0)
struct XcdBarrier { unsigned* bar; unsigned x; volatile LAS unsigned* st; };
__device__ __forceinline__ XcdBarrier xcd_barrier_post(unsigned* bar, volatile LAS unsigned* st) {
    XcdBarrier b; b.bar = bar; b.x = xb_xcc_id(); b.st = st;
    if (threadIdx.x == 0) (void)xb_add(&bar[XB_XCNT(b.x)], 1u);
    return b;
}
__device__ __forceinline__ void xcd_barrier_complete(unsigned* bar, unsigned x, unsigned& nloc, unsigned& nx) {
    const unsigned G = gridDim.x * gridDim.y * gridDim.z;
    unsigned sum, cnt, mine, sp = 0u;
    for (;;) {
        sum = 0u; cnt = 0u; mine = 0u;
#pragma unroll
        for (unsigned j = 0; j < 16; ++j) { const unsigned c = xb_ld(&bar[XB_XCNT(j)]); sum += c; cnt += (c > 0u) ? 1u : 0u; mine = (j == x) ? c : mine; }
        if (sum == G) break;
        __builtin_amdgcn_s_sleep(1);
        if ((++sp & 255u) == 0u) { if (xb_ld(&bar[XB_TMO])) break; if (sp > XB_SPIN_CAP) { atomicAdd(&bar[XB_TMO], 1u); break; } }
    }
    nloc = mine > 0u ? mine : 1u; nx = cnt > 0u ? cnt : 1u;
}
__device__ __forceinline__ void xcd_barrier(const XcdBarrier& b, bool leader) {
    asm volatile("s_waitcnt vmcnt(0)" ::: "memory");
    __syncthreads();
    if (leader) {
        unsigned* bar = b.bar;
        __builtin_amdgcn_s_waitcnt(0);
        unsigned nloc = b.st[0], nx = b.st[1];
        if (nloc == 0u) { xcd_barrier_complete(bar, b.x, nloc, nx); b.st[0] = nloc; b.st[1] = nx; }
        const unsigned old = xb_add(&bar[XB_XSUB(b.x)], 1u);
        const unsigned gen = old / nloc;
        if (old + 1u == (gen + 1u) * nloc) {
            __builtin_amdgcn_fence(__ATOMIC_RELEASE, "agent");
            asm volatile("s_waitcnt vmcnt(0)" ::: "memory");
            const unsigned og = xb_add(&bar[XB_TOP], 1u);
            const unsigned tg = og / nx;
            if (og + 1u == (tg + 1u) * nx) xb_add(&bar[XB_TOPGEN], 1u);
            else XB_SPIN(xb_ld(&bar[XB_TOPGEN]) == tg, bar);
            __builtin_amdgcn_fence(__ATOMIC_ACQUIRE, "agent");
            xb_add(&bar[XB_XGEN(b.x)], 1u);
            asm volatile("s_waitcnt vmcnt(0)" ::: "memory");
        } else {
            XB_SPIN(xb_ld(&bar[XB_XGEN(b.x)]) == gen, bar);
            __builtin_amdgcn_fence(__ATOMIC_ACQUIRE, "agent");
            asm volatile("s_waitcnt vmcnt(0)" ::: "memory");
        }
    }
    __syncthreads();
}

__device__ __forceinline__ int lane_id() { return (int)__builtin_amdgcn_mbcnt_hi(~0u, __builtin_amdgcn_mbcnt_lo(~0u, 0u)); }
#ifdef PROBE_SEL
__device__ __noinline__ void stamp_call(volatile LAS unsigned* st, int kind, int who) {
    if (who == 0 && lane_id() == 0) { const unsigned long long now_ = __builtin_amdgcn_s_memrealtime(); volatile LAS unsigned long long* T_ = (volatile LAS unsigned long long*)(st + 56); T_[1 + kind] += now_ - T_[0]; T_[0] = now_; } }
#endif
__device__ __noinline__ void xcd_barrier_call(unsigned* barw, unsigned x, volatile LAS unsigned* st, int wave, int kind, int who) {
#ifdef PROBE_SEL
    if (who == 0 && lane_id() == 0) { const unsigned long long now_ = __builtin_amdgcn_s_memrealtime(); volatile LAS unsigned long long* T_ = (volatile LAS unsigned long long*)(st + 56); T_[1 + kind] += now_ - T_[0]; T_[0] = now_; }
#endif
    XcdBarrier b; b.bar = barw; b.x = x; b.st = st; xcd_barrier(b, wave == 0 && lane_id() == 0);
#ifdef PROBE_SEL
    if (who == 0 && lane_id() == 0) { const unsigned long long now_ = __builtin_amdgcn_s_memrealtime(); volatile LAS unsigned long long* T_ = (volatile LAS unsigned long long*)(st + 56); T_[17] += now_ - T_[0]; T_[0] = now_; }
#endif
}
namespace pg8 {
constexpr int BM = 256, BK = 64, HALF = 128, HTB = HALF * BK * 2, STAGE_BYTES = 8 * HTB, NXCD = 8, WGM = 8;
__host__ __device__ __forceinline__ int lds_byte(int r, int c) { const int st = (r >> 4) * 2 + (c >> 5), rr = r & 15, cc = c & 31, ob = rr * 64 + cc * 2; return st * 1024 + (ob ^ (((ob >> 9) & 1) << 5)); }
__host__ __device__ __forceinline__ void stage_rc(int b, int& R, int& C) { const int st = b / 1024, sb = b % 1024, swz = sb ^ (((sb >> 9) & 1) << 5); R = (st >> 1) * 16 + swz / 64; C = (st & 1) * 32 + (swz % 64) / 2; }
__host__ __device__ __forceinline__ int perm32(int rho) { const int n = rho >> 4, i = rho & 15; return 8 * (i >> 2) + 4 * n + (i & 3); }

struct Unit { const char* A; const char* B; int pm, pn, br; };
struct TileOrder {
    int nM, nN, nwg, G, c, nbr;
    __device__ __forceinline__ void init(int M_, int N_, int G_, int c_, int nbr_ = 1) { nM = M_ / BM; nN = N_ / BM; nwg = nM * nN; G = G_; c = c_; nbr = nbr_; }
    __device__ __forceinline__ bool tile(int i, int& pm, int& pn, int& br) const {
        const int it = i / nbr; br = i - it * nbr;
        const long L = (long)it * G + c; if (L >= nwg) return false;
        int wgid = (int)L; { const int q = nwg / NXCD, r = nwg % NXCD, xcd = wgid % NXCD, off = wgid / NXCD; wgid = (xcd < r ? xcd * (q + 1) : r * (q + 1) + (xcd - r) * q) + off; }
        const int nig = WGM * nN, gid = wgid / nig, fm = gid * WGM, gsz = (nM - fm) < WGM ? (nM - fm) : WGM;
        pm = fm + ((wgid % nig) % gsz); pn = (wgid % nig) / gsz; return true;
    }
};
struct PlainSched {
    TileOrder T; const char* A; const char* B; size_t lda2, ldb2;
    __device__ __forceinline__ bool next(int i, Unit& u) const { int pm, pn, br; if (!T.tile(i, pm, pn, br)) return false; u.pm = pm; u.pn = pn; u.br = br; u.A = A + (size_t)pm * BM * lda2; u.B = B + (size_t)pn * BM * ldb2; return true; }
    static __device__ __forceinline__ size_t aoff(int t) { return (size_t)t * 128; }
};
struct Cat3Sched {
    TileOrder T; const char* A; const char* B; size_t lda2, ldb2;
    __device__ __forceinline__ bool next(int i, Unit& u) const { int pm, pn, br; if (!T.tile(i, pm, pn, br)) return false; u.pm = pm; u.pn = pn; u.br = br; u.A = A + (size_t)pm * BM * lda2; u.B = B + (size_t)pn * BM * ldb2; return true; }
    static __device__ __forceinline__ size_t aoff(int t) { const int br = t >> 3; return (size_t)((t & 7) * 128 + (br == 0 ? C_OA * 2 : (br == 1 ? C_OB * 2 : C_OC * 2))); }
};
template <class Epi, class Sched>
__device__ __forceinline__ void gemm_phase(LAS unsigned char* lds, const int tid_in, const int K, const size_t lda2, const size_t ldb2, const Sched& S, const Epi& E) {
    int tid = tid_in; asm volatile("" : "+v"(tid));
    const int wid = __builtin_amdgcn_readfirstlane(tid >> 6), lane = tid & 63, wr = wid >> 2, wc = wid & 3, fr = lane & 15, fq = lane >> 4;
    int nt = K / BK; asm volatile("" : "+s"(nt));
    unsigned voffA[2], voffB[2];
#pragma unroll
    for (int i = 0; i < 2; ++i) { int R, C; stage_rc(tid * 16 + i * 8192, R, C); const int Rb = Epi::PERM ? ((R & ~31) + perm32(R & 31)) : R;
        voffA[i] = (unsigned)((size_t)R * lda2 + C * 2); voffB[i] = (unsigned)((size_t)Rb * ldb2 + C * 2); }
    const size_t hstepA = (size_t)HALF * lda2, hstepB = (size_t)HALF * ldb2;
    const unsigned ldsw = (unsigned)wid * 1024u;
    const int aoff = lds_byte(wr * 64 + fr, fq * 8), boff = lds_byte(wc * 32 + fr, fq * 8);
#ifndef REP_MASK
#define REP_MASK 0
#endif
#define PG8_SA(b, h) (((b) * 2 + (h)) * HTB)
#define PG8_SB(b, h) ((4 + (b) * 2 + (h)) * HTB)
#define PG8_STAGE(bufoff, gbase, voff) do { _Pragma("unroll") for (int _i = 0; _i < 2; ++_i) \
        __builtin_amdgcn_global_load_lds((const unsigned*)((const char*)(gbase) + (voff)[_i]), (LAS unsigned*)(lds + (bufoff) + ldsw + _i * 8192), 16, 0, 0); } while (0)
#define PG8_LDA(dst, b, h) do { _Pragma("unroll") for (int m = 0; m < 4; ++m) _Pragma("unroll") for (int k = 0; k < 2; ++k) dst[m][k] = *(const LAS h16x8*)(lds + PG8_SA(b, h) + aoff + m * 2048 + k * 1024); } while (0)
#define PG8_LDB(dst, b, h) do { _Pragma("unroll") for (int n = 0; n < 2; ++n) _Pragma("unroll") for (int k = 0; k < 2; ++k) dst[n][k] = *(const LAS h16x8*)(lds + PG8_SB(b, h) + boff + n * 2048 + k * 1024); } while (0)
#define PG8_MMA(ai, bj, At, Bt) do { __builtin_amdgcn_s_setprio(1); _Pragma("unroll") for (int m = 0; m < 4; ++m) _Pragma("unroll") for (int n = 0; n < 2; ++n) _Pragma("unroll") for (int k = 0; k < 2; ++k) \
        acc[ai][bj][m][n] = __builtin_amdgcn_mfma_f32_16x16x32_f16(Bt[n][k], At[m][k], acc[ai][bj][m][n], 0, 0, 0); __builtin_amdgcn_s_setprio(0); } while (0)
#define PG8_WAIT_V(n) asm volatile("s_waitcnt vmcnt(" #n ")" ::: "memory")
#define PG8_WAIT_L(n) asm volatile("s_waitcnt lgkmcnt(" #n ")" ::: "memory")
#define PG8_BAR __builtin_amdgcn_s_barrier()
#define PG8_SCHED __builtin_amdgcn_sched_barrier(0)
    Unit cur, nxt; int ui = 0;
    if (!S.next(0, cur)) return;
    f32x4 acc[2][2][4][2];
#pragma unroll
    for (int a = 0; a < 2; ++a)
#pragma unroll
        for (int b = 0; b < 2; ++b)
#pragma unroll
            for (int m = 0; m < 4; ++m)
#pragma unroll
                for (int n = 0; n < 2; ++n) acc[a][b][m][n] = (f32x4){0.f, 0.f, 0.f, 0.f};
    h16x8 At[4][2], B0[2][2], B1[2][2];
    const char* cA = cur.A; const char* cB = cur.B;
    PG8_STAGE(PG8_SB(0, 0), cB, voffB); PG8_STAGE(PG8_SB(0, 1), cB + hstepB, voffB); PG8_STAGE(PG8_SA(0, 0), cA + Sched::aoff(0), voffA); PG8_STAGE(PG8_SA(0, 1), cA + Sched::aoff(0) + hstepA, voffA);
    if (wr == 1) PG8_BAR;
    PG8_WAIT_V(2); PG8_BAR;
    PG8_STAGE(PG8_SB(1, 0), cB + 128, voffB); PG8_STAGE(PG8_SA(1, 0), cA + Sched::aoff(1), voffA); PG8_STAGE(PG8_SB(1, 1), cB + hstepB + 128, voffB);
    PG8_WAIT_V(6); PG8_BAR;
    for (;;) {
        const bool has_next = S.next(ui + 1, nxt);
        const char* nA = has_next ? nxt.A : cA; const char* nB = has_next ? nxt.B : cB;
        for (int t = 0; t < nt; t += 2) {
            const bool last = (t == nt - 2);
            if constexpr (Epi::MID) if (t == 8 || t == 16) { unsigned z_ = 0u; asm volatile("" : "+v"(z_)); const int le = (int)__builtin_amdgcn_mbcnt_hi(~0u, __builtin_amdgcn_mbcnt_lo(~0u, z_));
                E.mid(acc, cur, wr, wc, le & 15, le >> 4, t >> 3); }
            const char* a1 = cA + Sched::aoff(t + 1);
            const char* a2 = last ? nA + Sched::aoff(0) : cA + Sched::aoff(t + 2); const char* b2 = last ? nB : cB + (size_t)(t + 2) * 128;
            const char* a3 = last ? nA + Sched::aoff(1) : cA + Sched::aoff(t + 3); const char* b3 = b2 + 128;
            PG8_LDB(B0, 0, 0); PG8_LDB(B1, 0, 1); PG8_SCHED; PG8_LDA(At, 0, 0); PG8_STAGE(PG8_SA(1, 1), a1 + hstepA, voffA);
            PG8_WAIT_V(8); PG8_WAIT_L(0); PG8_BAR; PG8_MMA(0, 0, At, B0); PG8_MMA(0, 1, At, B1); PG8_BAR; PG8_SCHED;
            PG8_LDA(At, 0, 1); PG8_STAGE(PG8_SB(0, 0), b2, voffB); PG8_STAGE(PG8_SB(0, 1), b2 + hstepB, voffB); PG8_STAGE(PG8_SA(0, 0), a2, voffA);
            PG8_WAIT_V(8); PG8_WAIT_L(0); PG8_BAR; PG8_MMA(1, 0, At, B0); PG8_MMA(1, 1, At, B1); PG8_BAR; PG8_SCHED;
            PG8_LDB(B0, 1, 0); PG8_LDB(B1, 1, 1); PG8_SCHED; PG8_LDA(At, 1, 0); PG8_STAGE(PG8_SA(0, 1), a2 + hstepA, voffA);
            PG8_WAIT_V(8); PG8_WAIT_L(0); PG8_BAR; PG8_MMA(0, 0, At, B0); PG8_MMA(0, 1, At, B1); PG8_BAR; PG8_SCHED;
            PG8_LDA(At, 1, 1); PG8_STAGE(PG8_SB(1, 0), b3, voffB); PG8_STAGE(PG8_SB(1, 1), b3 + hstepB, voffB); PG8_STAGE(PG8_SA(1, 0), a3, voffA);
            PG8_WAIT_V(8); PG8_WAIT_L(0); PG8_BAR; PG8_MMA(1, 0, At, B0); PG8_MMA(1, 1, At, B1); PG8_BAR; PG8_SCHED;
        }
        if (wr == 0) PG8_BAR;
        { unsigned z_ = 0u; asm volatile("" : "+v"(z_)); const int le = (int)__builtin_amdgcn_mbcnt_hi(~0u, __builtin_amdgcn_mbcnt_lo(~0u, z_));
          E(acc, cur, wr, wc, le & 15, le >> 4);
          if (((REP_MASK >> 16) & 1) && Epi::IDEMP) E(acc, cur, wr, wc, le & 15, le >> 4); }
        if (!has_next) break;
#pragma unroll
        for (int a = 0; a < 2; ++a)
#pragma unroll
            for (int b = 0; b < 2; ++b)
#pragma unroll
                for (int m = 0; m < 4; ++m)
#pragma unroll
                    for (int n = 0; n < 2; ++n) acc[a][b][m][n] = (f32x4){0.f, 0.f, 0.f, 0.f};
        cur = nxt; cA = nA; cB = nB; ++ui;
        if (wr == 1) PG8_BAR;
    }
    PG8_WAIT_V(0);
    PG8_BAR;
#undef PG8_SA
#undef PG8_SB
#undef PG8_STAGE
#undef PG8_LDA
#undef PG8_LDB
#undef PG8_MMA
#undef PG8_WAIT_V
#undef PG8_WAIT_L
#undef PG8_BAR
#undef PG8_SCHED
}

__device__ __forceinline__ float rstd_from_parts(const float* part, int row, float inv_n) {
    const f32x4* p = (const f32x4*)(part + (size_t)row * 16);
    const f32x4 a = p[0], b = p[1], c = p[2], d = p[3];
    const float s = ((a[0] + a[1]) + (a[2] + a[3])) + ((b[0] + b[1]) + (b[2] + b[3])) + ((c[0] + c[1]) + (c[2] + c[3])) + ((d[0] + d[1]) + (d[2] + d[3]));
    return __builtin_amdgcn_rsqf(s * inv_n + EPS);
}
__device__ __forceinline__ void store_tr8(h16* T, int ncols, int m, int c, const f32x4& v0, const f32x4& v1) {
    h16* p = T + ((size_t)(m >> 11) * ncols + c) * SEQ + (m & (SEQ - 1));
    p[0 * SEQ] = (h16)v0[0]; p[1 * SEQ] = (h16)v0[1]; p[2 * SEQ] = (h16)v0[2]; p[3 * SEQ] = (h16)v0[3];
    p[4 * SEQ] = (h16)v1[0]; p[5 * SEQ] = (h16)v1[1]; p[6 * SEQ] = (h16)v1[2]; p[7 * SEQ] = (h16)v1[3];
}
struct EpiScaleParts {
    static constexpr bool PERM = true; static constexpr bool MID = true; static constexpr bool IDEMP = true;
    h16* O; int ldc; const float* part; h16* HT; h16* AVT; h16* IKC; LAS unsigned char* tab;
    __device__ __forceinline__ void mid(f32x4 (&)[2][2][4][2], const Unit& u, int wr, int wc, int fr, int fq, int brn) const {
        if (brn == 1) { const int wid = wr * 4 + wc, lane = fq * 16 + fr; const float* src = part + (size_t)u.pm * BM * 16 + (wid * 64 + lane) * 4;
#pragma unroll
            for (int i = 0; i < 2; ++i) __builtin_amdgcn_global_load_lds((const unsigned*)(src + i * 2048), (LAS unsigned*)(tab + i * 8192 + wid * 1024), 16, 0, 0); }
    }
    __device__ __forceinline__ void operator()(const f32x4 (&acc)[2][2][4][2], const Unit& u, int wr, int wc, int fr, int fq) const {
        const int row0 = u.pm * BM + wr * 64 + fr, col0 = u.pn * BM + wc * 32 + 8 * fq;
        const LAS unsigned char* trow = tab + (wr * 64 + fr) * 64;
        const bool tr = u.pn >= 22;
        h16* Tk = HT + (size_t)((u.pn - 22) >> 1) * ((size_t)NB * 512 * SEQ); const int tc0 = ((u.pn - 22) & 1) * 256 + wc * 32 + 8 * fq;
#pragma unroll
        for (int g = 0; g < 8; ++g) { const int ai = g >> 2, m = g & 3; const int row = row0 + ai * HALF + m * 16;
            const LAS f32x4* tp = (const LAS f32x4*)(trow + (ai * HALF + m * 16) * 64);
            const f32x4 a = tp[0], bq = tp[1], c = tp[2], d = tp[3];
            const float s = ((a[0] + a[1]) + (a[2] + a[3])) + ((bq[0] + bq[1]) + (bq[2] + bq[3])) + ((c[0] + c[1]) + (c[2] + c[3])) + ((d[0] + d[1]) + (d[2] + d[3]));
            const float rs = __builtin_amdgcn_rsqf(s * (1.0f / 1024.0f) + EPS);
            h16* rowp = O + (size_t)row * ldc + col0;
#pragma unroll
            for (int bj = 0; bj < 2; ++bj) { const f32x4 v0 = acc[ai][bj][m][0] * rs, v1 = acc[ai][bj][m][1] * rs;
                if (tr) store_tr8(Tk, 512, row, tc0 + bj * HALF, v0, v1);
                else { u32x4 w; w.x = pkh(v0[0], v0[1]); w.y = pkh(v0[2], v0[3]); w.z = pkh(v1[0], v1[1]); w.w = pkh(v1[2], v1[3]);
                    *(u32x4*)(rowp + bj * HALF) = w;
                    if (bj == 1 && u.pn == 2) store_tr8(AVT, 128, row, wc * 32 + 8 * fq, v0, v1);
                    if (bj == 1 && u.pn == 8 && wc < 2) *(u32x4*)(IKC + (size_t)row * 64 + wc * 32 + 8 * fq) = w; } } }
    }
};
struct EpiKV {
    static constexpr bool PERM = true; static constexpr bool MID = false; static constexpr bool IDEMP = true;
    h16* KN; h16* VCT; const float* rstd;
    __device__ __forceinline__ void operator()(const f32x4 (&acc)[2][2][4][2], const Unit& u, int wr, int wc, int fr, int fq) const {
        const int row0 = u.pm * BM + wr * 64 + fr, c8 = wc * 32 + 8 * fq;
#pragma unroll
        for (int ai = 0; ai < 2; ++ai)
#pragma unroll
            for (int m = 0; m < 4; ++m) { const int row = row0 + ai * HALF + m * 16; const float rs = rstd[row];
                { const f32x4 v0 = acc[ai][0][m][0] * rs, v1 = acc[ai][0][m][1] * rs;
                  u32x4 w; w.x = pkh(v0[0], v0[1]); w.y = pkh(v0[2], v0[3]); w.z = pkh(v1[0], v1[1]); w.w = pkh(v1[2], v1[3]);
                  *(u32x4*)(KN + (size_t)row * 512 + u.pn * 128 + c8) = w; }
                { const f32x4 v0 = acc[ai][1][m][0] * rs, v1 = acc[ai][1][m][1] * rs;
                  store_tr8(VCT + (size_t)u.pn * 128 * SEQ, 512, row, c8, v0, v1); }
                asm volatile("" ::: "memory"); }
    }
};
struct EpiPlainDummy {
    static constexpr bool PERM = true; static constexpr bool MID = false; static constexpr bool IDEMP = true;
    h16* O; int ldc;
    __device__ __forceinline__ void operator()(const f32x4 (&acc)[2][2][4][2], const Unit& u, int wr, int wc, int fr, int fq) const {
        const int row0 = u.pm * BM + wr * 64 + fr, col0 = u.pn * BM + wc * 32 + 8 * fq;
#pragma unroll
        for (int ai = 0; ai < 2; ++ai)
#pragma unroll
            for (int m = 0; m < 4; ++m) { const int row = (row0 + ai * HALF + m * 16) & 1023; h16* rowp = O + (size_t)row * ldc + col0;
#pragma unroll
                for (int bj = 0; bj < 2; ++bj) { const f32x4 v0 = acc[ai][bj][m][0], v1 = acc[ai][bj][m][1];
                    u32x4 w; w.x = pkh(v0[0], v0[1]); w.y = pkh(v0[2], v0[3]); w.z = pkh(v1[0], v1[1]); w.w = pkh(v1[2], v1[3]);
                    *(u32x4*)(rowp + bj * HALF) = w; } }
    }
};
template <bool ROPE> struct EpiScaleRow {
    static constexpr bool PERM = true; static constexpr bool MID = false; static constexpr bool IDEMP = true;
    h16* O; int ldc; const float* rstd; const float* cosT; const float* sinT;
    __device__ __forceinline__ void operator()(const f32x4 (&acc)[2][2][4][2], const Unit& u, int wr, int wc, int fr, int fq) const {
        const int row0 = u.pm * BM + wr * 64 + fr, col0 = u.pn * BM + wc * 32 + 8 * fq;
#pragma unroll
        for (int ai = 0; ai < 2; ++ai)
#pragma unroll
            for (int m = 0; m < 4; ++m) { const int row = row0 + ai * HALF + m * 16; const float rs = rstd[row];
                h16* rowp = O + (size_t)row * ldc + col0;
#pragma unroll
                for (int bj = 0; bj < 2; ++bj) { f32x4 v0 = acc[ai][bj][m][0] * rs, v1 = acc[ai][bj][m][1] * rs;
                    if (ROPE) { const int c = col0 + bj * HALF, cm = c % 192;
                        if (cm >= 128) { const int i0 = (cm - 128) >> 1;
                            const f32x4 cs = *(const f32x4*)(cosT + (size_t)row * 32 + i0), sn = *(const f32x4*)(sinT + (size_t)row * 32 + i0);
                            const f32x4 a = v0, b = v1;
                            v0[0] = a[0] * cs[0] - a[1] * sn[0]; v0[1] = a[1] * cs[0] + a[0] * sn[0];
                            v0[2] = a[2] * cs[1] - a[3] * sn[1]; v0[3] = a[3] * cs[1] + a[2] * sn[1];
                            v1[0] = b[0] * cs[2] - b[1] * sn[2]; v1[1] = b[1] * cs[2] + b[0] * sn[2];
                            v1[2] = b[2] * cs[3] - b[3] * sn[3]; v1[3] = b[3] * cs[3] + b[2] * sn[3]; } }
                    u32x4 w; w.x = pkh(v0[0], v0[1]); w.y = pkh(v0[2], v0[3]); w.z = pkh(v1[0], v1[1]); w.w = pkh(v1[2], v1[3]);
                    *(u32x4*)(rowp + bj * HALF) = w; }
                asm volatile("" ::: "memory"); }
    }
};
struct EpiGate3 {
    static constexpr bool PERM = true; static constexpr bool IDEMP = true; static constexpr bool MID = true;
    h16* O; const h16* G; int ldg;
    __device__ __forceinline__ void mid(f32x4 (&acc)[2][2][4][2], const Unit& u, int wr, int wc, int fr, int fq, int brn) const {
        const int row0 = u.pm * BM + wr * 64 + fr, col0 = u.pn * BM + wc * 32 + 8 * fq;
        const h16* gbase = G + (size_t)row0 * ldg + col0 + (brn - 1) * 1024;
        h16x8 gb[2][2][4];
#define G3_LOAD(buf, pr) do { _Pragma("unroll") for (int s_ = 0; s_ < 2; ++s_) { const int g_ = 2 * (pr) + s_; const h16* gp_ = gbase + (size_t)((g_ >> 2) * HALF + (g_ & 3) * 16) * ldg; \
            gb[buf][s_][0] = *(const h16x8*)gp_; gb[buf][s_][1] = *(const h16x8*)(gp_ + HALF); gb[buf][s_][2] = *(const h16x8*)(gp_ + 1024); gb[buf][s_][3] = *(const h16x8*)(gp_ + 1024 + HALF); } } while (0)
        G3_LOAD(0, 0);
#pragma unroll
        for (int pr = 0; pr < 4; ++pr) {
            if (pr + 1 < 4) G3_LOAD((pr + 1) & 1, pr + 1);
            __builtin_amdgcn_sched_barrier(0);
#pragma unroll
            for (int s = 0; s < 2; ++s) { const int g = 2 * pr + s, ai = g >> 2, m = g & 3;
#pragma unroll
                for (int bj = 0; bj < 2; ++bj) { const h16x8 gx = gb[pr & 1][s][bj], gy = gb[pr & 1][s][2 + bj];
#pragma unroll
                    for (int j = 0; j < 4; ++j) {
                        acc[ai][bj][m][0][j] *= (1.0f + __builtin_amdgcn_exp2f(-1.4426950408889634f * (float)gy[j])) * __builtin_amdgcn_rcpf(1.0f + __builtin_amdgcn_exp2f(-1.4426950408889634f * (float)gx[j]));
                        acc[ai][bj][m][1][j] *= (1.0f + __builtin_amdgcn_exp2f(-1.4426950408889634f * (float)gy[4 + j])) * __builtin_amdgcn_rcpf(1.0f + __builtin_amdgcn_exp2f(-1.4426950408889634f * (float)gx[4 + j])); } } }
            __builtin_amdgcn_sched_barrier(0); }
#undef G3_LOAD
    }
    __device__ __forceinline__ void operator()(const f32x4 (&acc)[2][2][4][2], const Unit& u, int wr, int wc, int fr, int fq) const {
        const int row0 = u.pm * BM + wr * 64 + fr, col0 = u.pn * BM + wc * 32 + 8 * fq;
        const h16* gbase = G + (size_t)row0 * ldg + 2048 + col0;
        h16x8 gb[2][2][2];
#define G3_LOAD(buf, pr) do { _Pragma("unroll") for (int s_ = 0; s_ < 2; ++s_) { const int g_ = 2 * (pr) + s_; const h16* gp_ = gbase + (size_t)((g_ >> 2) * HALF + (g_ & 3) * 16) * ldg; \
            gb[buf][s_][0] = *(const h16x8*)gp_; gb[buf][s_][1] = *(const h16x8*)(gp_ + HALF); } } while (0)
        G3_LOAD(0, 0);
#pragma unroll
        for (int pr = 0; pr < 4; ++pr) {
            if (pr + 1 < 4) G3_LOAD((pr + 1) & 1, pr + 1);
            __builtin_amdgcn_sched_barrier(0);
#pragma unroll
            for (int s = 0; s < 2; ++s) { const int g = 2 * pr + s, ai = g >> 2, m = g & 3; const int row = row0 + ai * HALF + m * 16; h16* rowp = O + (size_t)row * 1024 + col0;
#pragma unroll
                for (int bj = 0; bj < 2; ++bj) { const h16x8 g8 = gb[pr & 1][s][bj];
                    f32x4 v0 = acc[ai][bj][m][0], v1 = acc[ai][bj][m][1];
#pragma unroll
                    for (int j = 0; j < 4; ++j) { v0[j] *= sigmoidf_((float)g8[j]); v1[j] *= sigmoidf_((float)g8[4 + j]); }
                    u32x4 w; w.x = pkh(v0[0], v0[1]); w.y = pkh(v0[2], v0[3]); w.z = pkh(v1[0], v1[1]); w.w = pkh(v1[2], v1[3]);
                    *(u32x4*)(rowp + bj * HALF) = w; } }
            __builtin_amdgcn_sched_barrier(0); }
#undef G3_LOAD
    }
};
struct EpiResidual {
    static constexpr bool PERM = true; static constexpr bool MID = false; static constexpr bool PRE = false; static constexpr bool IDEMP = false;
    h16* X16; float* part;
    __device__ __forceinline__ void operator()(const f32x4 (&acc)[2][2][4][2], const Unit& u, int wr, int wc, int fr, int fq) const {
        const int row0 = u.pm * BM + wr * 64 + fr, col0 = u.pn * BM + wc * 32 + 8 * fq;
        h16x8 bh[4][2];
#define RES_LOAD(slot, g_) do { const size_t o_ = (size_t)(row0 + ((g_) >> 2) * HALF + ((g_) & 3) * 16) * 1024 + col0; _Pragma("unroll") for (int bj_ = 0; bj_ < 2; ++bj_) bh[slot][bj_] = *(const h16x8*)(X16 + o_ + bj_ * HALF); } while (0)
        RES_LOAD(0, 0); RES_LOAD(1, 1); RES_LOAD(2, 2);
#pragma unroll
        for (int g = 0; g < 8; ++g) { const int ai = g >> 2, m = g & 3; const int row = row0 + ai * HALF + m * 16; const size_t off = (size_t)row * 1024 + col0; float ss = 0.f;
            if (g + 3 < 8) RES_LOAD((g + 3) & 3, g + 3);
#pragma unroll
            for (int bj = 0; bj < 2; ++bj) { const h16x8 hv = bh[g & 3][bj];
                f32x4 o0, o1; o0[0] = (float)hv[0]; o0[1] = (float)hv[1]; o0[2] = (float)hv[2]; o0[3] = (float)hv[3]; o1[0] = (float)hv[4]; o1[1] = (float)hv[5]; o1[2] = (float)hv[6]; o1[3] = (float)hv[7];
                o0 += acc[ai][bj][m][0]; o1 += acc[ai][bj][m][1];
                ss += ((o0[0] * o0[0] + o0[1] * o0[1]) + (o0[2] * o0[2] + o0[3] * o0[3])) + ((o1[0] * o1[0] + o1[1] * o1[1]) + (o1[2] * o1[2] + o1[3] * o1[3]));
                u32x4 wh; wh.x = pkh(o0[0], o0[1]); wh.y = pkh(o0[2], o0[3]); wh.z = pkh(o1[0], o1[1]); wh.w = pkh(o1[2], o1[3]);
                *(u32x4*)(X16 + off + bj * HALF) = wh; }
            ss += __shfl_xor(ss, 16); ss += __shfl_xor(ss, 32);
            if (fq == 0) part[(size_t)row * 16 + u.pn * 4 + wc] = ss; }
#undef RES_LOAD
    }
};
struct EpiSwiGLU {
    static constexpr bool PERM = true; static constexpr bool MID = true; static constexpr bool IDEMP = true;
    h16* O; const float* part; LAS unsigned char* tab;
    __device__ __forceinline__ void mid(f32x4 (&)[2][2][4][2], const Unit& u, int wr, int wc, int fr, int fq, int brn) const {
        if (brn == 1) { const int wid = wr * 4 + wc, lane = fq * 16 + fr; const float* src = part + (size_t)u.pm * BM * 16 + (wid * 64 + lane) * 4;
#pragma unroll
            for (int i = 0; i < 2; ++i) __builtin_amdgcn_global_load_lds((const unsigned*)(src + i * 2048), (LAS unsigned*)(tab + i * 8192 + wid * 1024), 16, 0, 0); }
    }
    __device__ __forceinline__ void operator()(const f32x4 (&acc)[2][2][4][2], const Unit& u, int wr, int wc, int fr, int fq) const {
        const int row0 = u.pm * BM + wr * 64 + fr, col0 = u.pn * HALF + wc * 32 + 8 * fq;
        const LAS unsigned char* trow = tab + (wr * 64 + fr) * 64;
#pragma unroll
        for (int g = 0; g < 8; ++g) { const int ai = g >> 2, m = g & 3; const int row = row0 + ai * HALF + m * 16;
            const LAS f32x4* tp = (const LAS f32x4*)(trow + (ai * HALF + m * 16) * 64);
            const f32x4 a = tp[0], bq = tp[1], c = tp[2], d = tp[3];
            const float s = ((a[0] + a[1]) + (a[2] + a[3])) + ((bq[0] + bq[1]) + (bq[2] + bq[3])) + ((c[0] + c[1]) + (c[2] + c[3])) + ((d[0] + d[1]) + (d[2] + d[3]));
            const float rs = __builtin_amdgcn_rsqf(s * (1.0f / 1024.0f) + EPS);
            float o[8];
#pragma unroll
            for (int n = 0; n < 2; ++n)
#pragma unroll
                for (int j = 0; j < 4; ++j) { const float gt = acc[ai][0][m][n][j] * rs, up = acc[ai][1][m][n][j] * rs; o[n * 4 + j] = gt * sigmoidf_(gt) * up; }
            u32x4 w; w.x = pkh(o[0], o[1]); w.y = pkh(o[2], o[3]); w.z = pkh(o[4], o[5]); w.w = pkh(o[6], o[7]);
            *(u32x4*)(O + (size_t)row * DFF + col0) = w; }
    }
};
}
struct Args { const float* in[20]; float* out; unsigned char* ws; int ph_lo, ph_hi; };
struct Frame {
    LAS unsigned char* lds;
    int tid, lane, wave, G, bid;
    unsigned char* ws;
    float* out;
};
__device__ __forceinline__ const float* arg_in(LAS unsigned char* lds, int i) { const u32x2 v = *(const LAS u32x2*)(lds + LDS_MISC + 512 + 8 * i);
    const unsigned long long p = ((unsigned long long)(unsigned)__builtin_amdgcn_readfirstlane((int)v.y) << 32) | (unsigned)__builtin_amdgcn_readfirstlane((int)v.x); return (const float*)(const __attribute__((address_space(1))) float*)p; }
#define FIN(i) (arg_in(F.lds, (i)))
enum { I_X = 0, I_POS, I_WIN, I_WUPA, I_WUPB, I_WUPC, I_WOUT, I_QNORM, I_WQB, I_KVNORM, I_WKVB, I_LBLOG, I_ONORM, I_RELB, I_ANORM, I_FNORM, I_WFG, I_WFU, I_WFD, I_FINAL };

template <class ColMap>
__device__ __forceinline__ void transpose_item(const float* W, int ldw, int K, h16* WT, const float* gain, LAS float* scr, int item, int nblk, int lane, const ColMap& cm, int ldo = 0) {
    if (ldo == 0) ldo = K;
    const int kb = item / nblk, nb = item % nblk, k0 = 64 * kb, n0 = 32 * nb;
    const int sc = cm(n0 + (lane & 31));
    float wv[32];
#pragma unroll
    for (int i = 0; i < 32; ++i) wv[i] = W[(size_t)(k0 + 2 * i + (lane >> 5)) * ldw + sc];
    if (gain) {
#pragma unroll
        for (int i = 0; i < 32; ++i) wv[i] *= gain[k0 + 2 * i + (lane >> 5)]; }
#pragma unroll
    for (int i = 0; i < 32; ++i) scr[(2 * i + (lane >> 5)) * 33 + (lane & 31)] = wv[i];
    LDS_WAIT(); asm volatile("" ::: "memory");
    const int c = lane & 7;
#pragma unroll
    for (int j = 0; j < 4; ++j) { const int n = (lane >> 3) + 8 * j; const LAS float* s = scr + (8 * c) * 33 + n;
        u32x4 o; o.x = pkh(s[0 * 33], s[1 * 33]); o.y = pkh(s[2 * 33], s[3 * 33]); o.z = pkh(s[4 * 33], s[5 * 33]); o.w = pkh(s[6 * 33], s[7 * 33]);
        *(u32x4*)(WT + (size_t)(n0 + n) * ldo + k0 + 8 * c) = o; }
    LDS_WAIT(); asm volatile("" ::: "memory");
}
struct MapIn { __device__ int operator()(int n) const {
        if (n < 1280) return n;
        if (n < 1792) return 2888 + (n - 1280);
        if (n < 2176) return 3400 + (n - 1792);
        if (n < 2240) return 1280 + (n - 2176);
        if (n < 2304) { const int p = n - 2240; return 4040 + ((p & 1) * 32 + (p >> 1)); }
        if (n < 2560) return 3784 + (n - 2304);
        if (n < 5632) return 4104 + (n - 2560);
        if (n < 6144) return 1352 + (n - 5632);
        if (n < 6656) return 1864 + (n - 6144);
        return 2376 + (n - 6656); } };
struct MapId { __device__ int operator()(int n) const { return n; } };
struct MapQb { __device__ int operator()(int n) const { const int h = n / 192, d = n % 192; if (d < 128) return n; const int p = d - 128; return h * 192 + 128 + ((p & 1) * 32 + (p >> 1)); } };
struct MapGU { __device__ int operator()(int n) const { const int u = n >> 8, w = n & 255; return 128 * u + (w & 127); } };

__device__ __forceinline__ int wave_max_i(int v) {
    v = max(v, __builtin_amdgcn_update_dpp(v, v, 0xB1, 0xF, 0xF, false));
    v = max(v, __builtin_amdgcn_update_dpp(v, v, 0x4E, 0xF, 0xF, false));
    v = max(v, __builtin_amdgcn_update_dpp(v, v, 0x141, 0xF, 0xF, false));
    v = max(v, __builtin_amdgcn_update_dpp(v, v, 0x140, 0xF, 0xF, false));
    return max(max(__builtin_amdgcn_readlane(v, 0), __builtin_amdgcn_readlane(v, 16)), max(__builtin_amdgcn_readlane(v, 32), __builtin_amdgcn_readlane(v, 48)));
}
__device__ __forceinline__ void ph0_convert(Frame& F, const Args& args, int l) {
    LAS float* scr = (LAS float*)(F.lds + F.wave * 8704);
    const int gw = F.bid * NWAVES + F.wave, NGW = F.G * NWAVES;
    unsigned char* ws = F.ws;
    constexpr int I_IN = 16 * 224, I_UP = 8 * 32, I_OUT = 16 * 32, I_QB = 6 * 24, I_KVB = 4 * 32, I_GU = 16 * 176, I_DN = 44 * 32;
    constexpr int NIT = I_IN + 3 * I_UP + I_OUT + I_QB + I_KVB + I_GU + I_DN;
    for (int it = gw; it < NIT; it += NGW) {
        int r = it;
        if (r < I_IN) { transpose_item(FIN(I_WIN) + (size_t)l * DM * IN_COLS, IN_COLS, DM, (h16*)(ws + WS_WIN), FIN(I_ANORM) + l * DM, scr, r, 224, F.lane, MapIn()); continue; } r -= I_IN;
        if (r < 3 * I_UP) { const int br = r / I_UP; r -= br * I_UP; const float* W = (br == 0 ? FIN(I_WUPA) : (br == 1 ? FIN(I_WUPB) : FIN(I_WUPC))) + (size_t)l * 512 * DM;
            transpose_item(W, DM, 512, (h16*)(ws + WS_WUP) + (size_t)br * 512, nullptr, scr, r, 32, F.lane, MapId(), 1536); continue; } r -= 3 * I_UP;
        if (r < I_OUT) { transpose_item(FIN(I_WOUT) + (size_t)l * DM * DM, DM, DM, (h16*)(ws + WS_WOUT), nullptr, scr, r, 32, F.lane, MapId()); continue; } r -= I_OUT;
        if (r < I_QB) { transpose_item(FIN(I_WQB) + (size_t)l * 384 * 768, 768, 384, (h16*)(ws + WS_WQB), FIN(I_QNORM) + l * 384, scr, r, 24, F.lane, MapQb()); continue; } r -= I_QB;
        if (r < I_KVB) { transpose_item(FIN(I_WKVB) + (size_t)l * 256 * 1024, 1024, 256, (h16*)(ws + WS_WKVB), FIN(I_KVNORM) + l * 256, scr, r, 32, F.lane, MapId()); continue; } r -= I_KVB;
        if (r < I_GU) { const int nb = r % 176; const bool up = ((nb * 32) & 255) >= 128;
            transpose_item((up ? FIN(I_WFU) : FIN(I_WFG)) + (size_t)l * DM * DFF, DFF, DM, (h16*)(ws + WS_WGU), FIN(I_FNORM) + l * DM, scr, r, 176, F.lane, MapGU()); continue; } r -= I_GU;
        transpose_item(FIN(I_WFD) + (size_t)l * DFF * DM, DM, DFF, (h16*)(ws + ((l & 1) ? WS_WDN2 : WS_WDN)), nullptr, scr, r, 32, F.lane, MapId());
    }
    const int gt = F.bid * NTHREADS + F.tid, NGT = F.G * NTHREADS;
    float* wiw = (float*)(ws + WS_SMALL + SM_WIW); float* lbv = (float*)(ws + WS_SMALL + SM_LB);
    for (int i = gt; i < DM * 8; i += NGT) { const int k = i >> 3, j = i & 7; wiw[i] = FIN(I_ANORM)[l * DM + k] * FIN(I_WIN)[(size_t)l * DM * IN_COLS + (size_t)k * IN_COLS + 1344 + j]; }
    for (int i = gt; i < 512; i += NGT) { const float* lg = FIN(I_LBLOG);
        const float v0 = lg[i], v1 = lg[512 + i], v2 = lg[1024 + i], v3 = lg[1536 + i]; const float mx = fmaxf(fmaxf(v0, v1), fmaxf(v2, v3));
        const float e0 = expf(v0 - mx), e1 = expf(v1 - mx), e2 = expf(v2 - mx), e3 = expf(v3 - mx), s = (e0 + e1) + (e2 + e3);
        float c = 0.f; if (l >= 1) c += e1 / s; if (l >= 2) c += e2 / s; if (l >= 3) c += e3 / s;
        lbv[i] = c; }
    if (l == 0) {
        const float* x = FIN(I_X); const int* pos = (const int*)FIN(I_POS);
        h16* x16 = (h16*)(ws + WS_X16); float* rsa = (float*)(ws + WS_RSA); float* cosT = (float*)(ws + WS_COS); float* sinT = (float*)(ws + WS_SIN);
        for (int m0 = gw; m0 < M; m0 += 4 * NGW) {
            f32x4 xv[4][4]; int pv[4];
#pragma unroll
            for (int u = 0; u < 4; ++u) { const int m = m0 + u * NGW < M ? m0 + u * NGW : m0; const f32x4* xr = (const f32x4*)(x + (size_t)m * DM) + F.lane;
#pragma unroll
                for (int j = 0; j < 4; ++j) xv[u][j] = xr[64 * j];
                pv[u] = pos[m]; }
#pragma unroll
            for (int u = 0; u < 4; ++u) { const int m = m0 + u * NGW; if (m >= M) break;
#pragma unroll
                for (int j = 0; j < 4; ++j) { const f32x4 v = xv[u][j]; float ss = (v[0] * v[0] + v[1] * v[1]) + (v[2] * v[2] + v[3] * v[3]);
                    u32x2 w; w.x = pkh(v[0], v[1]); w.y = pkh(v[2], v[3]); *((u32x2*)(x16 + (size_t)m * DM) + F.lane + 64 * j) = w;
                    ss += __shfl_xor(ss, 1); ss += __shfl_xor(ss, 2); ss += __shfl_xor(ss, 4); ss += __shfl_xor(ss, 8);
                    if ((F.lane & 15) == 0) rsa[(size_t)m * 16 + j * 4 + (F.lane >> 4)] = ss; }
                if (F.lane < 32) { const float inv_freq = exp2f(-(float)F.lane * (13.287712379549449f / 32.0f));
                    const float ang = (float)pv[u] * inv_freq; float sn, cs; sincosf(ang, &sn, &cs); cosT[(size_t)m * 32 + F.lane] = cs; sinT[(size_t)m * 32 + F.lane] = sn; } }
        }
        int* pmin32 = (int*)(ws + WS_SMALL + SM_PMIN); int* pmax64 = (int*)(ws + WS_SMALL + SM_PMAX);
        for (int g = gw; g < M / 64; g += NGW) { const int v = pos[g * 64 + F.lane];
            const int mx = wave_max_i(v), mn0 = -wave_max_i(F.lane < 32 ? -v : (int)0x80000000), mn1 = -wave_max_i(F.lane >= 32 ? -v : (int)0x80000000);
            if (F.lane == 0) { pmax64[g] = mx; pmin32[2 * g] = mn0; pmin32[2 * g + 1] = mn1; } }
    }
}

__device__ __forceinline__ float wave_sum_dpp(float v) {
    v += __builtin_bit_cast(float, __builtin_amdgcn_update_dpp(0, __builtin_bit_cast(int, v), 0xB1, 0xF, 0xF, true));
    v += __builtin_bit_cast(float, __builtin_amdgcn_update_dpp(0, __builtin_bit_cast(int, v), 0x4E, 0xF, 0xF, true));
    v += __builtin_bit_cast(float, __builtin_amdgcn_update_dpp(0, __builtin_bit_cast(int, v), 0x141, 0xF, 0xF, true));
    v += __builtin_bit_cast(float, __builtin_amdgcn_update_dpp(0, __builtin_bit_cast(int, v), 0x140, 0xF, 0xF, true));
    const int iv = __builtin_bit_cast(int, v);
    return (__builtin_bit_cast(float, __builtin_amdgcn_readlane(iv, 0)) + __builtin_bit_cast(float, __builtin_amdgcn_readlane(iv, 16))) + (__builtin_bit_cast(float, __builtin_amdgcn_readlane(iv, 32)) + __builtin_bit_cast(float, __builtin_amdgcn_readlane(iv, 48)));
}
__device__ __forceinline__ void ph2_rows(Frame& F) {
    unsigned char* ws = F.ws;
    LAS float* wiw_s = (LAS float*)(F.lds);
    { const float* wiw = (const float*)(ws + WS_SMALL + SM_WIW); for (int i = F.tid; i < DM * 8; i += NTHREADS) wiw_s[(i & 7) * DM + (i >> 3)] = wiw[i]; }
    __syncthreads();
    const int gw = F.bid * NWAVES + F.wave, NGW = F.G * NWAVES;
    const h16* P = (const h16*)(ws + WS_P); const h16* x16 = (const h16*)(ws + WS_X16);
    const float* rsa = (const float*)(ws + WS_RSA); const float* cosT = (const float*)(ws + WS_COS); const float* sinT = (const float*)(ws + WS_SIN);
    float* rq = (float*)(ws + WS_SMALL + SM_RSTDQ); float* rkv = (float*)(ws + WS_SMALL + SM_RSTDKV); float* iw = (float*)(ws + WS_SMALL + SM_IW); h16* kpe = (h16*)(ws + WS_KPE);
    for (int m0 = gw; m0 < M; m0 += 4 * NGW) {
        h16x2 cqv[4][3], ckvv[4][2], kpv[4]; h16x8 xv[4][2]; float rp[4]; float csv[4], snv[4];
#pragma unroll
        for (int u = 0; u < 4; ++u) { const int m = m0 + u * NGW < M ? m0 + u * NGW : m0; const h16* pr = P + (size_t)m * NP;
#pragma unroll
            for (int j = 0; j < 3; ++j) cqv[u][j] = *(const h16x2*)(pr + C_CQ + 2 * F.lane + 128 * j);
#pragma unroll
            for (int j = 0; j < 2; ++j) ckvv[u][j] = *(const h16x2*)(pr + C_CKV + 2 * F.lane + 128 * j);
            kpv[u] = *(const h16x2*)(pr + C_KPE + 2 * (F.lane & 31));
#pragma unroll
            for (int i = 0; i < 2; ++i) xv[u][i] = *(const h16x8*)(x16 + (size_t)m * DM + 8 * F.lane + 512 * i);
            rp[u] = rsa[(size_t)m * 16 + (F.lane & 15)];
            csv[u] = cosT[(size_t)m * 32 + (F.lane & 31)]; snv[u] = sinT[(size_t)m * 32 + (F.lane & 31)]; }
        float acc84[4][8];
#pragma unroll
        for (int u = 0; u < 4; ++u)
#pragma unroll
            for (int j = 0; j < 8; ++j) acc84[u][j] = 0.f;
#pragma unroll
        for (int i = 0; i < 2; ++i) { const int k0 = 8 * F.lane + 512 * i;
            float xf[4][8];
#pragma unroll
            for (int u = 0; u < 4; ++u)
#pragma unroll
                for (int e = 0; e < 8; ++e) xf[u][e] = (float)xv[u][i][e];
#pragma unroll
            for (int j = 0; j < 8; ++j) { const f32x4 w0 = *(const LAS f32x4*)(wiw_s + j * DM + k0), w1 = *(const LAS f32x4*)(wiw_s + j * DM + k0 + 4);
#pragma unroll
                for (int u = 0; u < 4; ++u)
                    acc84[u][j] += (xf[u][0] * w0[0] + xf[u][1] * w0[1]) + (xf[u][2] * w0[2] + xf[u][3] * w0[3]) + (xf[u][4] * w1[0] + xf[u][5] * w1[1]) + (xf[u][6] * w1[2] + xf[u][7] * w1[3]); } }
#pragma unroll
        for (int u = 0; u < 4; ++u) { const int m = m0 + u * NGW; if (m >= M) break;
            float sq = 0.f, skv = 0.f;
#pragma unroll
            for (int j = 0; j < 3; ++j) { const float a = (float)cqv[u][j].x, b = (float)cqv[u][j].y; sq += a * a + b * b; }
#pragma unroll
            for (int j = 0; j < 2; ++j) { const float a = (float)ckvv[u][j].x, b = (float)ckvv[u][j].y; skv += a * a + b * b; }
            float acc8[8];
            sq = wave_sum_dpp(sq); skv = wave_sum_dpp(skv);
#pragma unroll
            for (int j = 0; j < 8; ++j) acc8[j] = wave_sum_dpp(acc84[u][j]);
            const float s = wave_sum_dpp(F.lane < 16 ? rp[u] : 0.f);
            const float rsat = __builtin_amdgcn_rsqf(s * (1.0f / 1024.0f) + EPS);
            if (F.lane == 0) { rq[m] = __builtin_amdgcn_rsqf(sq * (1.0f / 384.0f) + EPS); rkv[m] = __builtin_amdgcn_rsqf(skv * (1.0f / 256.0f) + EPS); }
            if (F.lane < 8) { float v = acc8[0];
#pragma unroll
                for (int j = 1; j < 8; ++j) v = (F.lane == j) ? acc8[j] : v;
                iw[(size_t)m * 8 + F.lane] = v * rsat; }
            if (F.lane < 32) { const float ka = (float)kpv[u].x, kb = (float)kpv[u].y;
                *(unsigned*)(kpe + (size_t)m * 64 + 2 * F.lane) = pkh(ka * csv[u] - kb * snv[u], kb * csv[u] + ka * snv[u]); }
        }
    }
    __syncthreads();
}
__device__ __forceinline__ void hgrn_gate(float fr, float lb, float& lf, float& kin) {
    fr = fminf(fmaxf(fr, -30.f), 30.f); const float e = __builtin_amdgcn_exp2f(-1.4426950408889634f * fr), sg = __builtin_amdgcn_rcpf(1.0f + e);
    const float f = fmaxf(lb + (1.0f - lb) * sg, 1e-30f);
    lf = __logf(f);
    kin = (1.0f - lb) * (e * sg);
}
__device__ __forceinline__ void hgrn_gate_f(float fr, float lb, float& f, float& kin) {
    fr = fminf(fmaxf(fr, -30.f), 30.f); const float e = __builtin_amdgcn_exp2f(-1.4426950408889634f * fr), sg = __builtin_amdgcn_rcpf(1.0f + e);
    f = fmaxf(lb + (1.0f - lb) * sg, 1e-30f); kin = (1.0f - lb) * (e * sg);
}
__device__ __forceinline__ void hgrn_b1_unit(Frame& F, int b, int c) {
    unsigned char* ws = F.ws; const h16* HT = (const h16*)(ws + WS_HT);
    const float* lbv = (const float*)(ws + WS_SMALL + SM_LB); float* dc = (float*)(ws + WS_SMALL + SM_DC);
    unsigned short* ST = (unsigned short*)(ws + WS_ST);
    LAS unsigned char* khT = F.lds; LAS unsigned char* inT = F.lds + 65536;
    int col = F.tid; asm volatile("" : "+v"(col));
    const float lb = lbv[col];
    const h16* pf = HT + ((size_t)HT_F * NB * 512 + (size_t)b * 512 + col) * SEQ + c * 64; const h16* pi = HT + ((size_t)HT_I * NB * 512 + (size_t)b * 512 + col) * SEQ + c * 64;
    h16x8 fv[8];
#pragma unroll
    for (int ch = 0; ch < 8; ++ch) { fv[ch] = *(const h16x8*)(pf + 8 * ch); *(LAS u32x4*)(inT + col * 128 + ((ch ^ (col & 7)) * 16)) = *(const u32x4*)(pi + 8 * ch); }
    float R = 1.0f;
#pragma unroll
    for (int ch = 7; ch >= 0; --ch) { float kv[8];
#pragma unroll
        for (int j = 7; j >= 0; --j) { float f, kin; hgrn_gate_f((float)fv[ch][j], lb, f, kin); kv[j] = kin * R; R *= f; }
        u32x4 wk; wk.x = pkh(kv[0], kv[1]); wk.y = pkh(kv[2], kv[3]); wk.z = pkh(kv[4], kv[5]); wk.w = pkh(kv[6], kv[7]);
        *(LAS u32x4*)(khT + col * 128 + ((ch ^ (col & 7)) * 16)) = wk; }
    dc[(size_t)(b * 32 + c) * 512 + col] = R;
    __syncthreads();
    const int h = F.wave >> 1, kh = F.wave & 1, r = col & 31, hh = (col >> 5) & 1;
    unsigned short* out = ST + ((size_t)((b * 4 + h) * 32 + c)) * 16384;
    for (int vt = 0; vt < 4; ++vt) {
        f32x16 acc0 = {}, acc1 = {};
        const int arow = h * 128 + vt * 32 + r, brow0 = h * 128 + (2 * kh) * 32 + r, brow1 = brow0 + 32;
#pragma unroll
        for (int sg = 0; sg < 4; ++sg) { const int ch = 2 * sg + hh;
            const h16x8 a = *(const LAS h16x8*)(inT + arow * 128 + ((ch ^ (arow & 7)) * 16));
            const h16x8 b0 = *(const LAS h16x8*)(khT + brow0 * 128 + ((ch ^ (brow0 & 7)) * 16));
            const h16x8 b1 = *(const LAS h16x8*)(khT + brow1 * 128 + ((ch ^ (brow1 & 7)) * 16));
            acc0 = __builtin_amdgcn_mfma_f32_32x32x16_f16(b0, a, acc0, 0, 0, 0);
            acc1 = __builtin_amdgcn_mfma_f32_32x32x16_f16(b1, a, acc1, 0, 0, 0); }
        __builtin_amdgcn_sched_barrier(0); asm volatile("s_nop 15\n\ts_nop 15"); __builtin_amdgcn_sched_barrier(0);
#pragma unroll
        for (int g4 = 0; g4 < 4; ++g4) { unsigned short* op = out + (size_t)(vt * 32 + r) * 128 + (2 * kh) * 32 + 8 * g4 + 4 * hh;
            u32x2 w0, w1; w0.x = pkb(acc0[4 * g4 + 0], acc0[4 * g4 + 1]); w0.y = pkb(acc0[4 * g4 + 2], acc0[4 * g4 + 3]); w1.x = pkb(acc1[4 * g4 + 0], acc1[4 * g4 + 1]); w1.y = pkb(acc1[4 * g4 + 2], acc1[4 * g4 + 3]);
            *(u32x2*)op = w0; *(u32x2*)(op + 32) = w1; }
    }
    __syncthreads();
}
__device__ __forceinline__ void hgrn_scan_unit(Frame& F, int j, int dry = 0) {
    unsigned char* ws = F.ws; const float* dc = (const float*)(ws + WS_SMALL + SM_DC); unsigned short* ST = (unsigned short*)(ws + WS_ST);
    int tid_ = F.tid; asm volatile("" : "+v"(tid_));
    const int gid = j * NTHREADS + tid_, bh = gid >> 12, e = (gid & 4095) * 4, k = e & 127, b = bh >> 2, h = bh & 3;
    float s0 = 0.f, s1 = 0.f, s2 = 0.f, s3 = 0.f;
    for (int c0 = 0; c0 < 32; c0 += 16) {
        u32x2 u[16]; f32x4 d[16];
#pragma unroll
        for (int i = 0; i < 16; ++i) { u[i] = *(const u32x2*)(ST + ((size_t)(bh * 32 + c0 + i)) * 16384 + e); d[i] = *(const f32x4*)(dc + (size_t)(b * 32 + c0 + i) * 512 + h * 128 + k); }
#pragma unroll
        for (int i = 0; i < 16; ++i) { const int c = c0 + i; unsigned short* p = ST + ((size_t)(bh * 32 + c)) * 16384 + e;
            s0 = d[i][0] * s0 + __uint_as_float(u[i].x << 16); s1 = d[i][1] * s1 + __uint_as_float(u[i].x & 0xffff0000u);
            s2 = d[i][2] * s2 + __uint_as_float(u[i].y << 16); s3 = d[i][3] * s3 + __uint_as_float(u[i].y & 0xffff0000u);
            u32x2 w; w.x = pkb(s0, s1); w.y = pkb(s2, s3); *(u32x2*)(dry ? (unsigned short*)(ws + WS_X16) + ((size_t)(bh * 32 + c)) * 16384 + e : p) = w; }
    }
}
__device__ __forceinline__ void hgrn_b3_unit(Frame& F, const Args& args, int b, int c, int l, int hp_only, int dry = 0) {
    unsigned char* ws = F.ws; h16* P = (h16*)(ws + WS_P); const h16* HT = (const h16*)(ws + WS_HT);
    const float* lbv = (const float*)(ws + WS_SMALL + SM_LB); const unsigned short* ST = (const unsigned short*)(ws + WS_ST);
    const float* gain = FIN(I_ONORM) + l * 128;
    LAS unsigned char* QT = F.lds;
    LAS unsigned char* KB = F.lds + 32768;
    LAS unsigned char* inT = F.lds + 65536;
    LAS float* red = (LAS float*)(F.lds + 98304);
    const size_t m0 = (size_t)b * SEQ + (size_t)c * 64;
    int tid_ = F.tid; asm volatile("" : "+v"(tid_));
    const int colp = tid_ & 255, half = tid_ >> 8, hlA = colp >> 7, kA = colp & 127, rowi = tid_ >> 1, c0i = (tid_ & 1) * 4, hli = rowi >> 7, vi = rowi & 127;
    auto issue_loads = [&](int hp, h16x8 (&fv)[4], h16x8 (&qv8)[4], u32x4 (&iv)[4]) {
        const int h = 2 * hp + hlA;
        const h16* pf = HT + ((size_t)HT_F * NB * 512 + (size_t)b * 512 + h * 128 + kA) * SEQ + c * 64 + 32 * half; const h16* pq = HT + ((size_t)HT_Q * NB * 512 + (size_t)b * 512 + h * 128 + kA) * SEQ + c * 64 + 32 * half;
        const h16* pi = HT + ((size_t)HT_I * NB * 512 + (size_t)b * 512 + (2 * hp + hli) * 128 + vi) * SEQ + c * 64 + 8 * c0i;
#pragma unroll
        for (int ch = 0; ch < 4; ++ch) { fv[ch] = *(const h16x8*)(pf + 8 * ch); qv8[ch] = *(const h16x8*)(pq + 8 * ch); iv[ch] = *(const u32x4*)(pi + 8 * ch); }
    };
    h16x8 fvA[4], qvA[4], fvB[4], qvB[4]; u32x4 ivA[4], ivB[4];
    issue_loads(hp_only, fvA, qvA, ivA);
    auto do_pass = [&](int hp, h16x8 (&fv)[4], h16x8 (&qv8)[4], u32x4 (&iv)[4], h16x8 (&nfv)[4], h16x8 (&nqv)[4], u32x4 (&niv)[4]) {
        const int hl = F.wave >> 2, ti = (F.wave >> 1) & 1, vh = F.wave & 1, h = 2 * hp + hl, r = tid_ & 31, hh = (tid_ >> 5) & 1;
        bf16x8 sa0[8], sa1[8];
        {
            const float lb = lbv[(2 * hp + hlA) * 128 + kA];
#pragma unroll
            for (int ch = 0; ch < 4; ++ch) *(LAS u32x4*)(inT + rowi * 128 + (((c0i + ch) ^ (vi & 7)) * 16)) = iv[ch];
            float fa[32], kna[32]; float Lp = 1.0f;
#pragma unroll
            for (int ch = 0; ch < 4; ++ch)
#pragma unroll
                for (int j = 0; j < 8; ++j) { hgrn_gate_f((float)fv[ch][j], lb, fa[ch * 8 + j], kna[ch * 8 + j]); Lp *= fa[ch * 8 + j]; }
            if (half == 0) red[256 + colp] = Lp;
            __syncthreads();
            if (c > 0) { const unsigned short* Sp = ST + ((size_t)((b * 4 + h) * 32 + (c - 1))) * 16384;
#pragma unroll
                for (int ks = 0; ks < 8; ++ks) { sa0[ks] = *(const bf16x8*)(Sp + (size_t)((2 * vh) * 32 + r) * 128 + 16 * ks + 8 * hh); sa1[ks] = *(const bf16x8*)(Sp + (size_t)((2 * vh + 1) * 32 + r) * 128 + 16 * ks + 8 * hh); } }
            float Pr = half ? red[256 + colp] : 1.0f;
#pragma unroll
            for (int i = 0; i < 32; ++i) { const int s = 32 * half + i; Pr *= fa[i];
                const float Pc = fmaxf(Pr, 1.2e-37f); const float qv = (float)qv8[i >> 3][i & 7] * 0.08838834764831845f * Pc, kvv = kna[i] * __builtin_amdgcn_rcpf(Pc);
                const int off = hlA * 16384 + s * 256 + (((kA >> 3) ^ (s & 15)) * 16) + (kA & 7) * 2;
                *(LAS unsigned short*)(QT + off) = (unsigned short)(pkb(qv, 0.f) & 0xffffu); *(LAS unsigned short*)(KB + off) = (unsigned short)(pkb(kvv, 0.f) & 0xffffu); }
        }
        __syncthreads();
        f32x16 o0 = {}, o1 = {};
        const int trow = ti * 32 + r;
        const LAS unsigned char* qrow = QT + hl * 16384 + trow * 256;
        if (c > 0) {
#pragma unroll
            for (int ks = 0; ks < 8; ++ks) { const bf16x8 qb = *(const LAS bf16x8*)(qrow + (((2 * ks + hh) ^ (trow & 15)) * 16));
                o0 = __builtin_amdgcn_mfma_f32_32x32x16_bf16(sa0[ks], qb, o0, 0, 0, 0);
                o1 = __builtin_amdgcn_mfma_f32_32x32x16_bf16(sa1[ks], qb, o1, 0, 0, 0); }
        }
        for (int sj = 0; sj <= ti; ++sj) {
            f32x16 at = {};
            const int srow = sj * 32 + r; const LAS unsigned char* krow = KB + hl * 16384 + srow * 256;
#pragma unroll
            for (int ks = 0; ks < 8; ++ks) { const bf16x8 qb = *(const LAS bf16x8*)(qrow + (((2 * ks + hh) ^ (trow & 15)) * 16));
                const bf16x8 ka = *(const LAS bf16x8*)(krow + (((2 * ks + hh) ^ (srow & 15)) * 16));
                at = __builtin_amdgcn_mfma_f32_32x32x16_bf16(ka, qb, at, 0, 0, 0); }
            if (sj == ti) {
#pragma unroll
                for (int q = 0; q < 16; ++q) if (crow(q, hh) > r) at[q] = 0.f; }
#pragma unroll
            for (int sg = 0; sg < 2; ++sg) {
                u32x4 pw; pw.x = pkh(at[8 * sg + 0], at[8 * sg + 1]); pw.y = pkh(at[8 * sg + 2], at[8 * sg + 3]); pw.z = pkh(at[8 * sg + 4], at[8 * sg + 5]); pw.w = pkh(at[8 * sg + 6], at[8 * sg + 7]);
                const h16x8 pb = __builtin_bit_cast(h16x8, pw);
                const int ch = 4 * sj + 2 * sg;
#pragma unroll
                for (int vt = 0; vt < 2; ++vt) { const int vrow = (2 * vh + vt) * 32 + r; const LAS unsigned char* ir = inT + (hl * 128 + vrow) * 128 + 8 * hh;
                    const u32x2 lo = *(const LAS u32x2*)(ir + ((ch ^ (vrow & 7)) * 16)), hi2 = *(const LAS u32x2*)(ir + (((ch + 1) ^ (vrow & 7)) * 16));
                    u32x4 aw; aw.x = lo.x; aw.y = lo.y; aw.z = hi2.x; aw.w = hi2.y;
                    if (vt == 0) o0 = __builtin_amdgcn_mfma_f32_32x32x16_f16(__builtin_bit_cast(h16x8, aw), pb, o0, 0, 0, 0);
                    else o1 = __builtin_amdgcn_mfma_f32_32x32x16_f16(__builtin_bit_cast(h16x8, aw), pb, o1, 0, 0, 0); }
            }
        }
        const size_t m = m0 + trow; h16* orow = dry ? ((h16*)(ws + WS_X16) + m * 512 + h * 128) : (P + m * NP + C_OB + h * 128); const h16* grow = P + m * NP + C_BG + h * 128;
        h16x4 gvv[2][4];
#pragma unroll
        for (int vt = 0; vt < 2; ++vt)
#pragma unroll
            for (int g4 = 0; g4 < 4; ++g4) gvv[vt][g4] = *(const h16x4*)(grow + (2 * vh + vt) * 32 + 8 * g4 + 4 * hh);
        float ss = 0.f;
#pragma unroll
        for (int q = 0; q < 16; ++q) ss += o0[q] * o0[q] + o1[q] * o1[q];
        ss += __shfl_xor(ss, 32);
        if (hh == 0) red[F.wave * 32 + r] = ss;
        __syncthreads();
        const float tot = red[F.wave * 32 + r] + red[(F.wave ^ 1) * 32 + r];
        const float rs = __builtin_amdgcn_rsqf(tot * (1.0f / 128.0f) + EPS);
#pragma unroll
        for (int vt = 0; vt < 2; ++vt)
#pragma unroll
            for (int g4 = 0; g4 < 4; ++g4) { const int v0 = (2 * vh + vt) * 32 + 8 * g4 + 4 * hh;
                const h16x4 gv = gvv[vt][g4]; const f32x4 gn = *(const f32x4*)(gain + v0); float y[4];
#pragma unroll
                for (int j = 0; j < 4; ++j) { const float ov = (vt == 0 ? o0[4 * g4 + j] : o1[4 * g4 + j]); const float g = (float)gv[j]; y[j] = ov * rs * gn[j] * (g * sigmoidf_(g)); }
                u32x2 w; w.x = pkh(y[0], y[1]); w.y = pkh(y[2], y[3]); *(u32x2*)(orow + v0) = w; }
        __syncthreads();
    };
    do_pass(hp_only, fvA, qvA, ivA, fvB, qvB, ivB);
}
__device__ __forceinline__ unsigned fkey(float v) { unsigned u = __float_as_uint(v); u = (u & 0x80000000u) ? ~u : (u | 0x80000000u); return (v == 0.0f) ? 0x80000000u : u; }
__device__ __forceinline__ int wave_sum_i(int v) {
    v += __builtin_amdgcn_update_dpp(0, v, 0xB1, 0xF, 0xF, true);
    v += __builtin_amdgcn_update_dpp(0, v, 0x4E, 0xF, 0xF, true);
    v += __builtin_amdgcn_update_dpp(0, v, 0x141, 0xF, 0xF, true);
    v += __builtin_amdgcn_update_dpp(0, v, 0x140, 0xF, 0xF, true);
    return __builtin_amdgcn_readlane(v, 0) + __builtin_amdgcn_readlane(v, 16) + __builtin_amdgcn_readlane(v, 32) + __builtin_amdgcn_readlane(v, 48);
}
__device__ __forceinline__ float half_sum(float v) { const auto r = __builtin_amdgcn_permlane32_swap(__float_as_uint(v), __float_as_uint(v), false, false); return __uint_as_float(r[0]) + __uint_as_float(r[1]); }
__device__ __forceinline__ float half_max(float v) { const auto r = __builtin_amdgcn_permlane32_swap(__float_as_uint(v), __float_as_uint(v), false, false); return fmaxf(__uint_as_float(r[0]), __uint_as_float(r[1])); }
template <int NJ>
__device__ __forceinline__ void select_finish(const unsigned (&key)[NJ], unsigned T, int cgt, int ceq, int lane, unsigned long long* mrow) {
    int need = 256 - cgt; const bool all_eq = (ceq <= need);
#pragma unroll
    for (int j = 0; j < NJ; ++j) {
        const unsigned long long gt = __ballot(key[j] > T), eq = __ballot(key[j] == T); unsigned long long take;
        if (all_eq) take = eq;
        else { const int pc = __builtin_popcountll(eq);
            if (pc <= need) { take = eq; need -= pc; }
            else { unsigned long long mrem = eq; take = 0ull; for (int i = 0; i < need; ++i) { const unsigned long long low = mrem & (0ull - mrem); take |= low; mrem ^= low; } need = 0; } }
        if (lane == 0) mrow[j] = gt | take;
    }
    if (lane >= NJ && lane < 32) { unsigned zlo = 0u; asm volatile("" : "+v"(zlo)); mrow[lane] = (unsigned long long)zlo; }
}
template <int NJ>
__device__ __forceinline__ void select_rows2(const LAS float* srowA, int tA, unsigned long long* mrowA, int lane) {
    unsigned ka[NJ], kb[NJ];
#pragma unroll
    for (int j = 0; j < NJ; ++j) { const int s = j * 64 + lane; ka[j] = (s <= tA) ? fkey(srowA[s]) : 0u; kb[j] = (s <= tA + 1) ? fkey(srowA[2048 + s]) : 0u; }
    unsigned Ta = 0u, Tb = 0u; bool da = false, db = false;
    unsigned mxa = 0u, mxb = 0u;
#pragma unroll
    for (int j = 0; j < NJ; ++j) { mxa = max(mxa, ka[j]); mxb = max(mxb, kb[j]); }
    mxa = (unsigned)wave_max_i((int)(mxa ^ 0x80000000u)) ^ 0x80000000u; mxb = (unsigned)wave_max_i((int)(mxb ^ 0x80000000u)) ^ 0x80000000u;
    int cntA = NJ * 64, cntB = NJ * 64;
    for (int bit = 31; bit >= 0; --bit) { const unsigned ca = da ? Ta : (Ta | (1u << bit)), cb = db ? Tb : (Tb | (1u << bit)); int na = 0, nb = 0;
        if (!(ca > mxa && cb > mxb)) { int c0 = 0, c1 = 0, c2 = 0, c3 = 0;
#pragma unroll
            for (int j = 0; j < NJ; j += 2) { c0 += (ka[j] >= ca) ? 1 : 0; c1 += (ka[j + 1] >= ca) ? 1 : 0; c2 += (kb[j] >= cb) ? 1 : 0; c3 += (kb[j + 1] >= cb) ? 1 : 0; }
            const int pk = wave_sum_i((c0 + c1) | ((c2 + c3) << 16)); na = pk & 0xffff; nb = pk >> 16; }
        if (!da) { if (na >= 256) { Ta = ca; cntA = na; } if (na == 256) da = true; }
        if (!db) { if (nb >= 256) { Tb = cb; cntB = nb; } if (nb == 256) db = true; }
        if (da && db) break; }
    if (da || db) {
        unsigned ma = 0xffffffffu, mb2 = 0xffffffffu;
#pragma unroll
        for (int j = 0; j < NJ; ++j) { if (ka[j] >= Ta) ma = min(ma, ka[j]); if (kb[j] >= Tb) mb2 = min(mb2, kb[j]); }
        const unsigned wa = ~(unsigned)wave_max_i((int)(~ma ^ 0x80000000u)) ^ 0x80000000u, wb = ~(unsigned)wave_max_i((int)(~mb2 ^ 0x80000000u)) ^ 0x80000000u;
        if (da) Ta = wa; if (db) Tb = wb; }
    int ga = 0, gb = 0;
#pragma unroll
    for (int j = 0; j < NJ; ++j) { ga += (ka[j] > Ta) ? 1 : 0; gb += (kb[j] > Tb) ? 1 : 0; }
    const int pg = wave_sum_i(ga | (gb << 16)); const int cgta = pg & 0xffff, cgtb = pg >> 16;
    select_finish<NJ>(ka, Ta, cgta, cntA - cgta, lane, mrowA);
    select_finish<NJ>(kb, Tb, cgtb, cntB - cgtb, lane, mrowA + 32);
}
__device__ __forceinline__ void score_select_unit(Frame& F, int b, int g) {
    unsigned char* ws = F.ws; const h16* P = (const h16*)(ws + WS_P); const h16* IKC = (const h16*)(ws + WS_IKC);
    unsigned long long* mask = (unsigned long long*)(ws + WS_MASK);
    const int t0 = 16 * g; const size_t mb = (size_t)b * SEQ;
    int lane_ = F.lane; asm volatile("" : "+v"(lane_));
    if (g < 16) {
        for (int q = 2 * F.wave; q < 2 * F.wave + 2; ++q) { const int t = t0 + q;
            if (F.lane < 32) { const int lo = 64 * F.lane; unsigned long long w;
                if (t >= lo + 63) w = ~0ull; else if (t < lo) w = 0ull; else w = (1ull << (t - lo + 1)) - 1ull;
                mask[(mb + t) * 32 + F.lane] = w; } }
        return;
    }
    LAS float* sc = (LAS float*)F.lds;
    LAS float* iw_s = (LAS float*)(F.lds + 131072);
    const float* iw = (const float*)(ws + WS_SMALL + SM_IW);
    if (F.tid < 128) iw_s[F.tid] = iw[(mb + t0) * 8 + F.tid];
    const int r = lane_ & 31, hh = lane_ >> 5;
    h16x8 aq[4][4];
#pragma unroll
    for (int rt = 0; rt < 4; ++rt)
#pragma unroll
        for (int ks = 0; ks < 4; ++ks) aq[rt][ks] = *(const h16x8*)(P + (mb + t0 + 4 * rt + (r >> 3)) * NP + C_IQ + (r & 7) * 64 + 16 * ks + 8 * hh);
    __syncthreads();
    const int nkb = (t0 + 16 + 31) >> 5;
#ifndef REP_MASK
#define REP_MASK 0
#endif
    for (int rep_ = 0; rep_ < (((REP_MASK >> 13) & 1) ? 2 : 1); ++rep_) {
    h16x8 bk[4], bn[4], bm[4];
    if (F.wave < nkb) { const int k1 = (F.wave + 8 < nkb) ? F.wave + 8 : F.wave;
#pragma unroll
        for (int ks = 0; ks < 4; ++ks) { bk[ks] = *(const h16x8*)(IKC + (mb + F.wave * 32 + r) * 64 + 16 * ks + 8 * hh); bn[ks] = *(const h16x8*)(IKC + (mb + k1 * 32 + r) * 64 + 16 * ks + 8 * hh); } }
    for (int kb = F.wave; kb < nkb; kb += 8) {
        const int kn = (kb + 16 < nkb) ? kb + 16 : kb;
#pragma unroll
        for (int ks = 0; ks < 4; ++ks) bm[ks] = *(const h16x8*)(IKC + (mb + kn * 32 + r) * 64 + 16 * ks + 8 * hh);
#pragma unroll
        for (int rt = 0; rt < 4; ++rt) {
            f32x16 acc = {};
#pragma unroll
            for (int ks = 0; ks < 4; ++ks) acc = __builtin_amdgcn_mfma_f32_32x32x16_f16(aq[rt][ks], bk[ks], acc, 0, 0, 0);
#pragma unroll
            for (int qq = 0; qq < 4; ++qq) { const f32x4 w = *(const LAS f32x4*)(iw_s + (4 * rt + qq) * 8 + 4 * hh);
                float p = w[0] * fmaxf(acc[4 * qq + 0], 0.f) + w[1] * fmaxf(acc[4 * qq + 1], 0.f) + w[2] * fmaxf(acc[4 * qq + 2], 0.f) + w[3] * fmaxf(acc[4 * qq + 3], 0.f);
                p = half_sum(p);
                if (hh == 0) sc[(4 * rt + qq) * 2048 + kb * 32 + r] = p; }
        }
#pragma unroll
        for (int ks = 0; ks < 4; ++ks) { bk[ks] = bn[ks]; bn[ks] = bm[ks]; }
    }
    }
    __syncthreads();
    for (int rep_ = 0; rep_ < (((REP_MASK >> 14) & 1) ? 2 : 1); ++rep_) {
        const int q = 2 * F.wave, t = t0 + q; const int nj = ((t + 1) >> 6) + 1;
        unsigned long long* mrow = mask + (mb + t) * 32;
        if (nj <= 8) select_rows2<8>(sc + q * 2048, t, mrow, lane_);
        else if (nj <= 16) select_rows2<16>(sc + q * 2048, t, mrow, lane_);
        else if (nj <= 24) select_rows2<24>(sc + q * 2048, t, mrow, lane_);
        else select_rows2<32>(sc + q * 2048, t, mrow, lane_);
    }
    __syncthreads();
}

template <int MODE>
__device__ __forceinline__ void attn_unit(Frame& F, const Args& args, int b, int hsel, int qb, int dry = 0) {
    constexpr int DQK = MODE == 0 ? 192 : 128, NKS = DQK / 16, KROW = DQK * 2 + 16, KTILE = 64 * KROW, VROW = 144, VTILE = 128 * VROW, NKC = DQK / 8;
    unsigned char* ws = F.ws; h16* P = (h16*)(ws + WS_P);
    const h16* QC = (const h16*)(ws + WS_QC); const h16* KN = (const h16*)(ws + WS_KN); const h16* KPE = (const h16*)(ws + WS_KPE);
    const h16* VT = MODE == 0 ? ((const h16*)(ws + WS_VCT) + (size_t)(b * 4 + hsel) * 128 * SEQ) : ((const h16*)(ws + WS_AVT) + (size_t)b * 128 * SEQ);
    const unsigned* mask = (const unsigned*)(ws + WS_MASK); const int* pos = (const int*)FIN(I_POS);
    LAS unsigned char* Kl = F.lds;
    LAS unsigned char* Vl = F.lds + 2 * KTILE;
    LAS float* tabB = (LAS float*)(F.lds + 2 * KTILE + 2 * VTILE);
    LAS int* posk = (LAS int*)(F.lds + 2 * KTILE + 2 * VTILE + 2048);
    LAS unsigned* maskL = (LAS unsigned*)(F.lds + 2 * KTILE + 2 * VTILE + 2048 + 512);
    const size_t mb = (size_t)b * SEQ;
    int lane_ = F.lane; asm volatile("" : "+v"(lane_));
    int tid_ = F.tid; asm volatile("" : "+v"(tid_));
    const int r = lane_ & 31, hh = lane_ >> 5;
    const int head = MODE == 0 ? hsel : (F.wave >> 1);
    const int tq = MODE == 0 ? (qb * 256 + F.wave * 32 + r) : (qb * 64 + (F.wave & 1) * 32 + r);
    const int tq_hi = MODE == 0 ? (qb * 256 + F.wave * 32 + 31) : (qb * 64 + (F.wave & 1) * 32 + 31);
    const int nt = MODE == 0 ? (4 * qb + 4) : ((((REP_MASK >> 19) & 1) && dry) ? ((qb + 2) >> 1) : (qb + 1));
    constexpr float SCL = MODE == 0 ? 0.07216878364870322f : 0.08838834764831845f;
    constexpr float L2E = 1.4426950408889634f;
    if (MODE == 1) {
        if (tid_ < 128) { const int d = tid_; int bk;
            if (d < 16) bk = d; else bk = 16 + (d >= 19) + (d >= 21) + (d >= 24) + (d >= 27) + (d >= 31) + (d >= 35) + (d >= 40) + (d >= 46) + (d >= 52) + (d >= 59) + (d >= 67) + (d >= 77) + (d >= 87) + (d >= 99) + (d >= 113);
            const float* rb = FIN(I_RELB) + bk * 4; tabB[d * 4 + 0] = rb[0] * L2E; tabB[d * 4 + 1] = rb[1] * L2E; tabB[d * 4 + 2] = rb[2] * L2E; tabB[d * 4 + 3] = rb[3] * L2E; }
    }
    if (MODE == 1) {
#pragma unroll
        for (int i = 0; i < 2; ++i) { const int ci = tid_ + 512 * i, rowq = ci >> 4, cc = ci & 15;
            const u32x4 v = *(const u32x4*)(mask + (mb + qb * 64 + rowq) * 64 + 4 * cc);
            LAS unsigned* d = maskL + rowq * 66 + 4 * cc; d[0] = v.x; d[1] = v.y; d[2] = v.z; d[3] = v.w; }
    }
    h16x8 qf[NKS];
    { const h16* qp = MODE == 0 ? (QC + (mb + tq) * 768 + head * 192) : (P + (mb + tq) * NP + C_AQ + head * 128);
#pragma unroll
        for (int ks = 0; ks < NKS; ++ks) qf[ks] = *(const h16x8*)(qp + 16 * ks + 8 * hh) * (h16)(SCL * L2E); }
    const int posq = MODE == 1 ? pos[mb + tq] : 0;
    unsigned farbits = 0u;
    if (MODE == 1) { const int* pmin32 = (const int*)(ws + WS_SMALL + SM_PMIN); const int* pmax64 = (const int*)(ws + WS_SMALL + SM_PMAX);
        const int pqmin = pmin32[b * 64 + qb * 2 + (F.wave & 1)]; const int km = pmax64[b * 32 + r];
        farbits = (unsigned)__ballot(pqmin - km >= 127); }
    const int skey = tid_ >> 3, sc8 = tid_ & 7;
    u32x4 stK[NKC / 8], stV[2]; int stPos = 0;
    const int vd_ = tid_ >> 2, vg_ = tid_ & 3;
    auto load_tile = [&](int kt) {
        const size_t km = mb + (size_t)kt * 64 + skey;
        if (MODE == 0) { const h16* kn = KN + km * 512 + head * 128;
            stK[0] = *(const u32x4*)(kn + 8 * sc8); stK[1] = *(const u32x4*)(kn + 64 + 8 * sc8); stK[2] = *(const u32x4*)(KPE + km * 64 + 8 * sc8); }
        else { const h16* kp = P + km * NP + C_AK;
            stK[0] = *(const u32x4*)(kp + 8 * sc8); stK[1] = *(const u32x4*)(kp + 64 + 8 * sc8);
            if (sc8 == 0) stPos = pos[km]; }
        const h16* vp = VT + (size_t)vd_ * SEQ + kt * 64 + 16 * vg_;
        stV[0] = *(const u32x4*)vp; stV[1] = *(const u32x4*)(vp + 8);
    };
    auto store_tile = [&](int buf) {
        LAS unsigned char* kd = Kl + buf * KTILE + skey * KROW + sc8 * 16;
#pragma unroll
        for (int i = 0; i < NKC / 8; ++i) *(LAS u32x4*)(kd + 128 * i) = stK[i];
        LAS unsigned char* vd = Vl + buf * VTILE + vd_ * VROW + vg_ * 32;
        u32x4 c0, c1; c0.x = stV[0].x; c0.y = stV[0].y; c0.z = stV[1].x; c0.w = stV[1].y; c1.x = stV[0].z; c1.y = stV[0].w; c1.z = stV[1].z; c1.w = stV[1].w;
        *(LAS u32x4*)vd = c0; *(LAS u32x4*)(vd + 16) = c1;
        if (MODE == 1 && sc8 == 0) posk[buf * 64 + skey] = stPos;
    };
    float m_run = -1e30f, l_run = 0.f;
    f32x16 o[4]; o[0] = f32x16{}; o[1] = f32x16{}; o[2] = f32x16{}; o[3] = f32x16{};
    load_tile(0); store_tile(0);
    __syncthreads();
    const int nt_w = MODE == 1 ? nt : (tq_hi >> 6) + 1;
    float bcfar = 0.f;
    if (MODE == 1) bcfar = __builtin_bit_cast(float, __builtin_amdgcn_readfirstlane(__builtin_bit_cast(int, tabB[127 * 4 + head])));
    auto tile = [&](int kt) {
        const int buf = kt & 1;
        if (MODE == 1) asm volatile("; ATTN1_TILE_BEGIN"); else asm volatile("; ATTN0_TILE_BEGIN");
        if (kt + 1 < nt) load_tile(kt + 1);
        {
            f32x16 s0 = {}, s1 = {};
            const LAS unsigned char* kb_ = Kl + buf * KTILE + r * KROW + hh * 16;
            constexpr int NG = NKS / 2;
            h16x8 kf[2][4];
#define LDKG(g, dst) do { _Pragma("unroll") for (int i_ = 0; i_ < 2; ++i_) { const int ks_ = 2 * (g) + i_; \
                dst[2 * i_] = *(const LAS h16x8*)(kb_ + ks_ * 32); dst[2 * i_ + 1] = *(const LAS h16x8*)(kb_ + ks_ * 32 + 32 * KROW); } } while (0)
            LDKG(0, kf[0]);
#pragma unroll
            for (int g = 0; g < NG; ++g) {
                if (g + 1 < NG) LDKG(g + 1, kf[(g + 1) & 1]);
#pragma unroll
                for (int i = 0; i < 2; ++i) { s0 = __builtin_amdgcn_mfma_f32_32x32x16_f16(kf[g & 1][2 * i], qf[2 * g + i], s0, 0, 0, 0);
                    s1 = __builtin_amdgcn_mfma_f32_32x32x16_f16(kf[g & 1][2 * i + 1], qf[2 * g + i], s1, 0, 0, 0); }
                __builtin_amdgcn_sched_barrier(0);
            }
#undef LDKG
            float bc = 0.f; unsigned mw0 = 0u, mw1 = 0u;
            if (MODE == 1) {
                const LAS unsigned* mrow_ = maskL + ((F.wave & 1) * 32 + r) * 66 + 2 * kt;
                mw0 = mrow_[0] >> (4 * hh); mw1 = mrow_[1] >> (4 * hh);
                if ((farbits >> kt) & 1u) bc = bcfar;
                else {
#pragma unroll
                    for (int q = 0; q < 16; ++q) { const int kl = (q & 3) + 8 * (q >> 2) + 4 * hh;
                        int d0 = posq - posk[buf * 64 + kl]; d0 = d0 < 0 ? 0 : (d0 > 127 ? 127 : d0);
                        int d1 = posq - posk[buf * 64 + 32 + kl]; d1 = d1 < 0 ? 0 : (d1 > 127 ? 127 : d1);
                        float a0 = s0[q], a1 = s1[q];
                        asm("v_add_f32 %0, %0, %1" : "+v"(a0) : "v"(tabB[d0 * 4 + head]));
                        asm("v_add_f32 %0, %0, %1" : "+v"(a1) : "v"(tabB[d1 * 4 + head]));
                        s0[q] = a0; s1[q] = a1; }
                }
            }
            float pmax = s0[0];
#pragma unroll
            for (int q = 1; q < 16; ++q) pmax = fmaxf(pmax, s0[q]);
#pragma unroll
            for (int q = 0; q < 16; ++q) pmax = fmaxf(pmax, s1[q]);
            pmax = half_max(pmax) + bc;
            const float m_new = fmaxf(m_run, pmax);
            const float alpha = __builtin_amdgcn_exp2f(m_run - m_new);
            m_run = m_new;
            const float mm = m_new - bc - 8.0f;
            const f32x2_t mm2 = {mm, mm};
#pragma unroll
            for (int q = 0; q < 16; q += 2) { f32x2_t t0 = {s0[q], s0[q + 1]}, t1 = {s1[q], s1[q + 1]}; t0 -= mm2; t1 -= mm2;
                s0[q] = __builtin_amdgcn_exp2f(t0.x); s0[q + 1] = __builtin_amdgcn_exp2f(t0.y); s1[q] = __builtin_amdgcn_exp2f(t1.x); s1[q + 1] = __builtin_amdgcn_exp2f(t1.y); }
            if (MODE == 1) {
#pragma unroll
                for (int q = 0; q < 16; ++q) { const int c = (q & 3) + 8 * (q >> 2);
                    int b0, b1; asm("v_bfe_i32 %0, %1, %2, 1" : "=v"(b0) : "v"(mw0), "n"(c)); asm("v_bfe_i32 %0, %1, %2, 1" : "=v"(b1) : "v"(mw1), "n"(c));
                    const float e0 = s0[q], e1 = s1[q];
                    s0[q] = __int_as_float(__float_as_int(e0) & b0); s1[q] = __int_as_float(__float_as_int(e1) & b1); }
            } else if (kt == nt_w - 1) {
                const int nv0 = tq - 64 * kt + 1, nv1 = nv0 - 32;
                mw0 = (nv0 >= 32 ? 0xffffffffu : ((1u << nv0) - 1u)) >> (4 * hh); mw1 = (nv1 >= 32 ? 0xffffffffu : (nv1 <= 0 ? 0u : ((1u << nv1) - 1u))) >> (4 * hh);
#pragma unroll
                for (int q = 0; q < 16; ++q) { const int c = (q & 3) + 8 * (q >> 2);
                    float a0 = s0[q], a1 = s1[q];
                    asm("v_and_b32 %0, %0, %1" : "+v"(a0) : "v"(__builtin_amdgcn_sbfe((int)mw0, c, 1)));
                    asm("v_and_b32 %0, %0, %1" : "+v"(a1) : "v"(__builtin_amdgcn_sbfe((int)mw1, c, 1)));
                    s0[q] = a0; s1[q] = a1; }
            }
            f32x2_t ps2 = {0.f, 0.f};
#pragma unroll
            for (int q = 0; q < 16; q += 2) { ps2 += f32x2_t{s0[q], s0[q + 1]}; ps2 += f32x2_t{s1[q], s1[q + 1]}; }
            const float ps = half_sum(ps2.x + ps2.y);
            l_run = l_run * alpha + ps;
            if (__any(alpha != 1.0f)) {
#pragma unroll
                for (int dt = 0; dt < 4; ++dt)
#pragma unroll
                    for (int q = 0; q < 16; ++q) o[dt][q] *= alpha; }
            __builtin_amdgcn_sched_barrier(0);
            const LAS unsigned char* vb = Vl + buf * VTILE + r * VROW + hh * 16;
            h16x8 vf[2][4];
#define LDVG(G, dst) do { _Pragma("unroll") for (int dt_ = 0; dt_ < 4; ++dt_) dst[dt_] = *(const LAS h16x8*)(vb + (G) * 32 + dt_ * 32 * VROW); } while (0)
            LDVG(0, vf[0]);
#pragma unroll
            for (int G = 0; G < 4; ++G) { const int kbk = G >> 1, sg = G & 1;
                if (G + 1 < 4) LDVG(G + 1, vf[(G + 1) & 1]);
                u32x4 pw;
                if (kbk == 0) { pw.x = pkh(s0[8 * sg + 0], s0[8 * sg + 1]); pw.y = pkh(s0[8 * sg + 2], s0[8 * sg + 3]); pw.z = pkh(s0[8 * sg + 4], s0[8 * sg + 5]); pw.w = pkh(s0[8 * sg + 6], s0[8 * sg + 7]); }
                else { pw.x = pkh(s1[8 * sg + 0], s1[8 * sg + 1]); pw.y = pkh(s1[8 * sg + 2], s1[8 * sg + 3]); pw.z = pkh(s1[8 * sg + 4], s1[8 * sg + 5]); pw.w = pkh(s1[8 * sg + 6], s1[8 * sg + 7]); }
                const h16x8 pb = __builtin_bit_cast(h16x8, pw);
#pragma unroll
                for (int dt = 0; dt < 4; ++dt) o[dt] = __builtin_amdgcn_mfma_f32_32x32x16_f16(vf[G & 1][dt], pb, o[dt], 0, 0, 0);
                __builtin_amdgcn_sched_barrier(0);
            }
#undef LDVG
        }
        if (kt + 1 < nt) store_tile(buf ^ 1);
        __syncthreads();
        if (MODE == 1) asm volatile("; ATTN1_TILE_END"); else asm volatile("; ATTN0_TILE_END");
    };
    for (int kt = 0; kt < nt_w; ++kt) tile(kt);
    for (int kt = nt_w; kt < nt; ++kt) {
        if (kt + 1 < nt) { load_tile(kt + 1); store_tile((kt & 1) ^ 1); }
        __syncthreads();
    }
    const float rl = __builtin_amdgcn_rcpf(l_run);
    h16* op = dry ? ((h16*)(ws + WS_X16) + (mb + tq) * 512 + head * 128) : (P + (mb + tq) * NP + (MODE == 0 ? C_OC : C_OA) + head * 128);
#pragma unroll
    for (int dt = 0; dt < 4; ++dt)
#pragma unroll
        for (int g4 = 0; g4 < 4; ++g4) { const int d0 = 32 * dt + 8 * g4 + 4 * hh;
            u32x2 w; w.x = pkh(o[dt][4 * g4 + 0] * rl, o[dt][4 * g4 + 1] * rl); w.y = pkh(o[dt][4 * g4 + 2] * rl, o[dt][4 * g4 + 3] * rl);
            *(u32x2*)(op + d0) = w; }
    __syncthreads();
}
#ifndef MK_SINGLE
#define MK_SINGLE 1
#endif
#define PHEN(k) ((KMASK >> (k)) & 1)
constexpr int PH_PER_LAYER = 9, PH_FINAL = NL * PH_PER_LAYER, PH_COUNT = PH_FINAL + 1;

__device__ __forceinline__ Frame phase_frame(const Frame& F) {
    Frame P = F; unsigned z = 0u; asm volatile("" : "+v"(z)); const int ln = (int)__builtin_amdgcn_mbcnt_hi(~0u, __builtin_amdgcn_mbcnt_lo(~0u, z)); P.lane = ln; P.tid = F.wave * 64 + ln;
    unsigned long long w = (unsigned long long)F.ws; asm volatile("" : "+s"(w)); P.ws = (unsigned char*)(__attribute__((address_space(1))) unsigned char*)w;
    unsigned long long o = (unsigned long long)F.out; asm volatile("" : "+s"(o)); P.out = (float*)(__attribute__((address_space(1))) float*)o;
    int g = F.G, bd = F.bid, wv = F.wave; unsigned ld = (unsigned)(unsigned long long)F.lds; asm volatile("" : "+s"(g), "+s"(bd), "+s"(wv), "+s"(ld));
    P.G = g; P.bid = bd; P.wave = wv; P.lds = (LAS unsigned char*)ld; P.tid = wv * 64 + ln; return P; }
#ifndef REP_MASK
#define REP_MASK 0
#endif
#define REPN(k) (((REP_MASK >> (k)) & 1) ? 2 : 1)
#ifdef PROBE_SEL
#define STAMP(k) stamp_call(MISC + 8, (k), F.bid * NWAVES + F.wave)
#else
#define STAMP(k) do { } while (0)
#endif
template <int KMASK> __global__ void __launch_bounds__(NTHREADS, 2) mk_fwd(Args args) {
    extern __shared__ __attribute__((aligned(16))) unsigned char lds_raw[];
    Frame F;
    F.lds = (LAS unsigned char*)lds_raw;
    F.tid = threadIdx.x; F.lane = F.tid & 63; F.wave = __builtin_amdgcn_readfirstlane(F.tid >> 6);
    F.G = gridDim.x; F.bid = blockIdx.x; F.ws = args.ws; F.out = args.out;
    volatile LAS unsigned* MISC = (volatile LAS unsigned*)(F.lds + LDS_MISC);
    for (int u = F.tid; u < 128; u += NTHREADS) MISC[u] = 0u;
    if (F.tid < 20) *(LAS unsigned long long*)(F.lds + LDS_MISC + 512 + 8 * F.tid) = (unsigned long long)args.in[F.tid];
    __syncthreads();
    const int lo = args.ph_lo, hi = args.ph_hi;
#ifdef PROBE_SEL
    if (F.bid == 0 && F.tid == 0) { volatile LAS unsigned long long* T_ = (volatile LAS unsigned long long*)(MISC + 8 + 56); for (int i = 1; i < 24; ++i) T_[i] = 0ull; T_[0] = __builtin_amdgcn_s_memrealtime(); }
    __syncthreads();
#endif
    XcdBarrier bar; bar.bar = (unsigned*)(F.ws + WS_CTL) + 4096; bar.x = 0; bar.st = nullptr;
    if (hi - lo > 1) bar = xcd_barrier_post((unsigned*)(F.ws + WS_CTL) + 4096, MISC + 8);
#define IN(k) (lo <= (k) && (k) < hi)
#define SEAM(k) do { if ((k) + 1 < hi) { xcd_barrier_call(bar.bar, bar.x, bar.st, F.wave, (k) % PH_PER_LAYER, F.bid * NWAVES + F.wave); if ((REP_MASK >> 15) & 1) xcd_barrier_call(bar.bar, bar.x, bar.st, F.wave, (k) % PH_PER_LAYER, F.bid * NWAVES + F.wave); } } while (0)
    for (int l = 0; l < NL; ++l) {
        const int p0 = l * PH_PER_LAYER;
        if (PHEN(0) && IN(p0 + 0) && l == 0) { Frame Fp = phase_frame(F); unsigned char* ws = Fp.ws; asm volatile("; PHASE_MARK 0"); for (int rep = 0; rep < REPN(0); ++rep) ph0_convert(Fp, args, l); SEAM(p0 + 0); }
        if (PHEN(1) && IN(p0 + 1)) { Frame Fp = phase_frame(F); unsigned char* ws = Fp.ws; asm volatile("; PHASE_MARK 1");
            pg8::PlainSched S; S.T.init(M, NPROJ, Fp.G, Fp.bid); S.A = (const char*)(ws + WS_X16); S.B = (const char*)(ws + WS_WIN); S.lda2 = DM * 2; S.ldb2 = DM * 2;
            if ((REP_MASK >> 17) & 1) { pg8::EpiPlainDummy Ed{(h16*)(ws + WS_QC), NPROJ}; pg8::gemm_phase(Fp.lds, Fp.tid, DM, S.lda2, S.ldb2, S, Ed); }
            pg8::EpiScaleParts E{(h16*)(ws + WS_P), NP, (const float*)(ws + WS_RSA), (h16*)(ws + WS_HT), (h16*)(ws + WS_AVT), (h16*)(ws + WS_IKC), Fp.lds + pg8::STAGE_BYTES};
            for (int rep = 0; rep < REPN(1); ++rep) pg8::gemm_phase(Fp.lds, Fp.tid, DM, S.lda2, S.ldb2, S, E);
            SEAM(p0 + 1);
        }
        if (PHEN(2) && IN(p0 + 2)) { Frame Fp = phase_frame(F); unsigned char* ws = Fp.ws; asm volatile("; PHASE_MARK 2");
            if ((REP_MASK >> 27) & 1) { if (Fp.bid & 1) { const unsigned long long t0_ = __builtin_amdgcn_s_memrealtime(); while (__builtin_amdgcn_s_memrealtime() - t0_ < 10000ull) __builtin_amdgcn_s_sleep(8); } }
            for (int rep = 0; rep < REPN(2); ++rep) { if (!(rep == 1 && ((REP_MASK >> 25) & 1))) for (int u = Fp.bid; u < NB * 32; u += Fp.G) hgrn_b1_unit(Fp, u >> 5, u & 31);
            if (!(rep == 1 && ((REP_MASK >> 26) & 1))) ph2_rows(Fp); }
            SEAM(p0 + 2);
        }
        if (PHEN(3) && IN(p0 + 3)) { Frame Fp = phase_frame(F); unsigned char* ws = Fp.ws; asm volatile("; PHASE_MARK 3");
            { pg8::PlainSched S; S.T.init(M, 768, Fp.G, Fp.bid); S.A = (const char*)(ws + WS_P) + C_CQ * 2; S.B = (const char*)(ws + WS_WQB); S.lda2 = NP * 2; S.ldb2 = 384 * 2;
              pg8::EpiScaleRow<true> E{(h16*)(ws + WS_QC), 768, (const float*)(ws + WS_SMALL + SM_RSTDQ), (const float*)(ws + WS_COS), (const float*)(ws + WS_SIN)};
              for (int rep = 0; rep < REPN(3); ++rep) pg8::gemm_phase(Fp.lds, Fp.tid, 384, S.lda2, S.ldb2, S, E); }
        }

        if (PHEN(11) && IN(p0 + 3)) { Frame Fp = phase_frame(F); unsigned char* ws = Fp.ws; asm volatile("; PHASE_MARK 11");
            { pg8::PlainSched S; S.T.init(M, 1024, Fp.G, Fp.bid); S.A = (const char*)(ws + WS_P) + C_CKV * 2; S.B = (const char*)(ws + WS_WKVB); S.lda2 = NP * 2; S.ldb2 = 256 * 2;
              pg8::EpiKV E{(h16*)(ws + WS_KN), (h16*)(ws + WS_VCT), (const float*)(ws + WS_SMALL + SM_RSTDKV)};
              for (int rep = 0; rep < REPN(11); ++rep) pg8::gemm_phase(Fp.lds, Fp.tid, 256, S.lda2, S.ldb2, S, E); }
        }

        if (PHEN(10) && IN(p0 + 3)) { Frame Fp = phase_frame(F); unsigned char* ws = Fp.ws; asm volatile("; PHASE_MARK 10");
            for (int rep = 0; rep < REPN(10); ++rep) { int dry = (rep + 1 < REPN(10)); asm volatile("" : "+s"(dry));
            if (!(dry && ((REP_MASK >> 23) & 1))) for (int u = Fp.bid; u < NB * 128; u += Fp.G) { const int j = u >> 8, i = u & 255, gi = i >> 3; const int g = j * 32 + ((j & 1) ? (31 - gi) : gi); score_select_unit(Fp, i & 7, g); }
            if (!(dry && ((REP_MASK >> 24) & 1))) for (int u = Fp.bid; u < 256; u += Fp.G) hgrn_scan_unit(Fp, u, dry); }
        }
        if ((PHEN(3) || PHEN(10) || PHEN(11)) && IN(p0 + 3)) { SEAM(p0 + 3); }
        if (PHEN(4) && IN(p0 + 4)) { Frame Fp = phase_frame(F); unsigned char* ws = Fp.ws; asm volatile("; PHASE_MARK 4");
            for (int rep = 0; rep < REPN(4); ++rep) { int dry = (rep + 1 < REPN(4)); asm volatile("" : "+s"(dry));
            unsigned* qctr = (unsigned*)(ws + WS_CTL) + 8192 + 64 * l + 16 * rep;
            for (;;) {
                if (Fp.tid == 0) { const unsigned uu = __hip_atomic_fetch_add(qctr, 1u, __ATOMIC_RELAXED, __HIP_MEMORY_SCOPE_AGENT); MISC[16] = (uu < 1024u) ? (((uu & 7u) << 7) | (uu >> 3)) : 0xffffffffu; }
                __syncthreads();
                const unsigned code = MISC[16];
                if (code == 0xffffffffu) break;
                const int ub = (int)(code >> 7), u = (int)(code & 127u);
                int kind, uq, uh = 0;
                if (u < 16) { kind = 1; uq = 31 - u; }
                else if (u < 64) { const int v = u - 16, k = v / 6, w = v - 6 * k;
                    if (w < 4) { kind = 0; uh = w; uq = 7 - k; } else { kind = 1; uq = 15 - 2 * k - (w - 4); } }
                else { kind = 2; uq = (u - 64) >> 1; uh = (u - 64) & 1; }
#ifdef PERT_SEL
                const unsigned long long pt0_ = __builtin_amdgcn_s_memrealtime();
#endif
                if (dry && ((REP_MASK >> (20 + kind)) & 1)) continue;
                if (kind == 0) attn_unit<0>(Fp, args, ub, uh, uq, dry);
                else if (kind == 1) attn_unit<1>(Fp, args, ub, 0, uq, dry);
                else hgrn_b3_unit(Fp, args, ub, uq, l, uh, dry);
#ifdef PERT_SEL
                if (Fp.bid == 0 && Fp.tid == 0 && kind == PERT_SEL) { volatile LAS unsigned* PT = MISC + 32; const unsigned dt_ = (unsigned)(__builtin_amdgcn_s_memrealtime() - pt0_);
                    PT[0] += dt_; PT[1] += (kind == 0) ? (unsigned)(4 * uq + 4) : ((kind == 1) ? (unsigned)(uq + 1) : 1u); }
#endif
            }
            __syncthreads(); }
            SEAM(p0 + 4);
        }
        if (PHEN(5) && IN(p0 + 5)) { Frame Fp = phase_frame(F); unsigned char* ws = Fp.ws; asm volatile("; PHASE_MARK 5");
            pg8::Cat3Sched S; S.T.init(M, DM, Fp.G, Fp.bid); S.A = (const char*)(ws + WS_P); S.B = (const char*)(ws + WS_WUP); S.lda2 = NP * 2; S.ldb2 = 1536 * 2;
            pg8::EpiGate3 E{(h16*)(ws + WS_MIX), (const h16*)(ws + WS_P) + C_G, NP};
            for (int rep = 0; rep < REPN(5); ++rep) pg8::gemm_phase(Fp.lds, Fp.tid, 1536, S.lda2, S.ldb2, S, E);
            SEAM(p0 + 5);
        }
        if (PHEN(6) && IN(p0 + 6)) { Frame Fp = phase_frame(F); unsigned char* ws = Fp.ws; asm volatile("; PHASE_MARK 6");
            pg8::PlainSched S; S.T.init(M, DM, Fp.G, Fp.bid); S.A = (const char*)(ws + WS_MIX); S.B = (const char*)(ws + WS_WOUT); S.lda2 = DM * 2; S.ldb2 = DM * 2;
            if (REPN(6) == 2) { pg8::EpiResidual Ed{(h16*)(ws + WS_HT), (float*)(ws + WS_HT + 32 * MiB)};
                pg8::gemm_phase(Fp.lds, Fp.tid, DM, S.lda2, S.ldb2, S, Ed); }
            pg8::EpiResidual E{(h16*)(ws + WS_X16), (float*)(ws + WS_RSF)};
            pg8::gemm_phase(Fp.lds, Fp.tid, DM, S.lda2, S.ldb2, S, E);
            SEAM(p0 + 6);
        }
        if (PHEN(7) && IN(p0 + 7)) { Frame Fp = phase_frame(F); unsigned char* ws = Fp.ws; asm volatile("; PHASE_MARK 7");
            pg8::PlainSched S; S.T.init(M, 2 * DFF, Fp.G, Fp.bid); S.A = (const char*)(ws + WS_X16); S.B = (const char*)(ws + WS_WGU); S.lda2 = DM * 2; S.ldb2 = DM * 2;
            pg8::EpiSwiGLU E{(h16*)(ws + WS_ACT), (const float*)(ws + WS_RSF), Fp.lds + pg8::STAGE_BYTES};
            for (int rep = 0; rep < REPN(7); ++rep) pg8::gemm_phase(Fp.lds, Fp.tid, DM, S.lda2, S.ldb2, S, E);
            SEAM(p0 + 7);
        }
        if (PHEN(8) && IN(p0 + 8)) { Frame Fp = phase_frame(F); unsigned char* ws = Fp.ws; asm volatile("; PHASE_MARK 8");
            pg8::PlainSched S; S.T.init(M, DM, Fp.G, Fp.bid); S.A = (const char*)(ws + WS_ACT); S.B = (const char*)(ws + ((l & 1) ? WS_WDN2 : WS_WDN)); S.lda2 = DFF * 2; S.ldb2 = DFF * 2;
            if (REPN(8) == 2) { pg8::EpiResidual Ed{(h16*)(ws + WS_HT), (float*)(ws + WS_HT + 32 * MiB)};
                pg8::gemm_phase(Fp.lds, Fp.tid, DFF, S.lda2, S.ldb2, S, Ed); }
            pg8::EpiResidual E{(h16*)(ws + WS_X16), (float*)(ws + WS_RSA)};
            pg8::gemm_phase(Fp.lds, Fp.tid, DFF, S.lda2, S.ldb2, S, E);
            if (l + 1 < NL) ph0_convert(Fp, args, l + 1);
            SEAM(p0 + 8);
        }
    }
#ifdef PROBE_SEL
    {
        float* pv = (float*)(F.ws + WS_CTL + 512 * 1024);
        if (F.bid == 0 && F.wave == 0 && lane_id() == 0) { volatile LAS unsigned long long* T_ = (volatile LAS unsigned long long*)(MISC + 8 + 56); unsigned long long s = 0ull;
            for (int i = 0; i < 23; ++i) if ((PROBE_SEL >> i) & 1) s += T_[1 + i];
            __hip_atomic_store(pv, sqrtf((float)s * 0.01f / PROBE_SCALE), __ATOMIC_RELAXED, __HIP_MEMORY_SCOPE_AGENT); }
        xcd_barrier_call(bar.bar, bar.x, bar.st, F.wave, 20, 1);
        const float av = __hip_atomic_load(pv, __ATOMIC_RELAXED, __HIP_MEMORY_SCOPE_AGENT);
        Frame Fp = phase_frame(F);
        for (size_t i = (size_t)Fp.bid * NTHREADS + Fp.tid; i < (size_t)M * DM; i += (size_t)Fp.G * NTHREADS) Fp.out[i] = av;
        return;
    }
#endif
#ifdef PERT_SEL
    float pert_scale = 1.0f;
    if (IN(PH_FINAL)) { float* pv = (float*)(F.ws + WS_CTL + 768 * 1024);
        if (F.bid == 0 && F.wave == 0 && lane_id() == 0) { volatile LAS unsigned* PT = MISC + 32; const float avg_us = PT[1] ? (float)PT[0] * 0.01f / (float)PT[1] : 0.f;
            __hip_atomic_store(pv, sqrtf(1e-4f * avg_us / PERT_SCALE), __ATOMIC_RELAXED, __HIP_MEMORY_SCOPE_AGENT); }
        xcd_barrier_call(bar.bar, bar.x, bar.st, F.wave, 20, 1);
        pert_scale = 1.0f + __hip_atomic_load(pv, __ATOMIC_RELAXED, __HIP_MEMORY_SCOPE_AGENT); }
#endif
    if (PHEN(9) && IN(PH_FINAL)) { Frame Fp = phase_frame(F); unsigned char* ws = Fp.ws; asm volatile("; PHASE_MARK 9");
        const int gw = Fp.bid * NWAVES + Fp.wave, NGW = Fp.G * NWAVES; const f32x4* gn = (const f32x4*)arg_in(Fp.lds, I_FINAL);
        f32x4 gnv[4];
#pragma unroll
        for (int j = 0; j < 4; ++j) gnv[j] = gn[Fp.lane + 64 * j];
        for (int m0 = gw; m0 < M; m0 += 4 * NGW) {
            h16x4 hv[4][4];
#pragma unroll
            for (int u = 0; u < 4; ++u) { const int m = m0 + u * NGW < M ? m0 + u * NGW : m0; const h16x4* xh = (const h16x4*)((const h16*)(ws + WS_X16) + (size_t)m * DM) + Fp.lane;
#pragma unroll
                for (int j = 0; j < 4; ++j) hv[u][j] = xh[64 * j]; }
#pragma unroll
            for (int u = 0; u < 4; ++u) { const int m = m0 + u * NGW; if (m >= M) break;
                f32x4* xr = (f32x4*)(Fp.out + (size_t)m * DM) + Fp.lane; f32x4 v[4]; float ss = 0.f;
#pragma unroll
                for (int j = 0; j < 4; ++j) { v[j][0] = (float)hv[u][j][0]; v[j][1] = (float)hv[u][j][1]; v[j][2] = (float)hv[u][j][2]; v[j][3] = (float)hv[u][j][3]; ss += (v[j][0] * v[j][0] + v[j][1] * v[j][1]) + (v[j][2] * v[j][2] + v[j][3] * v[j][3]); }
                float rs = __builtin_amdgcn_rsqf(wave_sum(ss) * (1.0f / DM) + EPS);
#ifdef PERT_SEL
                rs *= pert_scale;
#endif
#pragma unroll
                for (int j = 0; j < 4; ++j) xr[64 * j] = v[j] * rs * gnv[j]; } }
    }
#undef IN
#undef SEAM
}

extern "C" void kernel_launch(void* const* d_in, const int* in_sizes, int n_in, void* d_out, int out_size, void* d_ws, size_t ws_size, hipStream_t stream) {
    static int grid = 0;
    if (grid == 0) {
        if (n_in != 20 || out_size != M * DM || ws_size < WS_END) { fprintf(stderr, "kernel_launch: unexpected shapes (n_in %d out %d ws %zu need %zu)\n", n_in, out_size, ws_size, (size_t)WS_END); grid = -1; return; }
        int dev = 0, cus = 0, per_cu = 0;
        if (hipGetDevice(&dev) != hipSuccess || hipDeviceGetAttribute(&cus, hipDeviceAttributeMultiprocessorCount, dev) != hipSuccess) { grid = -1; return; }
#if MK_SINGLE
        if (hipFuncSetAttribute((const void*)mk_fwd<0xfff>, hipFuncAttributeMaxDynamicSharedMemorySize, LDS_BYTES) != hipSuccess) { fprintf(stderr, "kernel_launch: hipFuncSetAttribute failed\n"); grid = -1; return; }
        if (hipOccupancyMaxActiveBlocksPerMultiprocessor(&per_cu, (const void*)mk_fwd<0xfff>, NTHREADS, LDS_BYTES) != hipSuccess || per_cu < 1) { fprintf(stderr, "kernel_launch: occupancy query says %d\n", per_cu); grid = -1; return; }
#else
        { const void* fns[12] = {(const void*)mk_fwd<1024>, (const void*)mk_fwd<2048>, (const void*)mk_fwd<1>, (const void*)mk_fwd<2>, (const void*)mk_fwd<4>, (const void*)mk_fwd<8>, (const void*)mk_fwd<16>, (const void*)mk_fwd<32>, (const void*)mk_fwd<64>, (const void*)mk_fwd<128>, (const void*)mk_fwd<256>, (const void*)mk_fwd<512>};
          for (int i = 0; i < 12; ++i) if (hipFuncSetAttribute(fns[i], hipFuncAttributeMaxDynamicSharedMemorySize, LDS_BYTES) != hipSuccess) { fprintf(stderr, "kernel_launch: hipFuncSetAttribute failed\n"); grid = -1; return; } }
        (void)per_cu;
#endif
        (void)hipGetLastError();
        grid = cus;
    }
    if (grid < 0) return;
#if defined(PROBE_SEL) || defined(PERT_SEL)
    (void)hipMemsetAsync((char*)d_ws + WS_CTL, 0, CTL_BYTES, stream);
#else
    (void)hipMemsetAsync((char*)d_ws + WS_CTL, 0, 64 * 1024, stream);
#endif
    Args a{};
    for (int i = 0; i < 20; ++i) a.in[i] = (const float*)d_in[i];
    a.out = (float*)d_out; a.ws = (unsigned char*)d_ws;
#if MK_SINGLE
    a.ph_lo = 0; a.ph_hi = PH_COUNT;
    hipLaunchKernelGGL(mk_fwd<0xfff>, dim3(grid), dim3(NTHREADS), LDS_BYTES, stream, a);
#else
    for (int p = 0; p < PH_COUNT; ++p) { a.ph_lo = p; a.ph_hi = p + 1; const int k = (p == PH_FINAL) ? 9 : (p % PH_PER_LAYER);
        switch (k) {
            case 0: hipLaunchKernelGGL(mk_fwd<1>, dim3(grid), dim3(NTHREADS), LDS_BYTES, stream, a); break;
            case 1: hipLaunchKernelGGL(mk_fwd<2>, dim3(grid), dim3(NTHREADS), LDS_BYTES, stream, a); break;
            case 2: hipLaunchKernelGGL(mk_fwd<4>, dim3(grid), dim3(NTHREADS), LDS_BYTES, stream, a); break;
            case 3: hipLaunchKernelGGL(mk_fwd<8>, dim3(grid), dim3(NTHREADS), LDS_BYTES, stream, a); hipLaunchKernelGGL(mk_fwd<2048>, dim3(grid), dim3(NTHREADS), LDS_BYTES, stream, a); hipLaunchKernelGGL(mk_fwd<1024>, dim3(grid), dim3(NTHREADS), LDS_BYTES, stream, a); break;
            case 4: hipLaunchKernelGGL(mk_fwd<16>, dim3(grid), dim3(NTHREADS), LDS_BYTES, stream, a); break;
            case 5: hipLaunchKernelGGL(mk_fwd<32>, dim3(grid), dim3(NTHREADS), LDS_BYTES, stream, a); break;
            case 6: hipLaunchKernelGGL(mk_fwd<64>, dim3(grid), dim3(NTHREADS), LDS_BYTES, stream, a); break;
            case 7: hipLaunchKernelGGL(mk_fwd<128>, dim3(grid), dim3(NTHREADS), LDS_BYTES, stream, a); break;
            case 8: hipLaunchKernelGGL(mk_fwd<256>, dim3(grid), dim3(NTHREADS), LDS_BYTES, stream, a); break;
            default: hipLaunchKernelGGL(mk_fwd<512>, dim3(grid), dim3(NTHREADS), LDS_BYTES, stream, a); break;
        } }
#endif
}
```

```cpp
#include <hip/hip_runtime.h>
#include <cstdio>
#include <cstdint>

#define LAS __attribute__((address_space(3)))
typedef _Float16 h16;
typedef _Float16 h16x8 __attribute__((ext_vector_type(8)));
typedef _Float16 h16x4 __attribute__((ext_vector_type(4)));
typedef _Float16 h16x2 __attribute__((ext_vector_type(2)));
typedef short bf16x8 __attribute__((ext_vector_type(8)));
typedef short s16x4 __attribute__((ext_vector_type(4)));
typedef float f32x2 __attribute__((ext_vector_type(2)));
typedef float f32x4 __attribute__((ext_vector_type(4)));
typedef float f32x16 __attribute__((ext_vector_type(16)));
typedef unsigned u32x2 __attribute__((ext_vector_type(2)));
typedef unsigned u32x4 __attribute__((ext_vector_type(4)));

constexpr int NB = 8, SEQ = 2048, M = NB * SEQ, DM = 1024, NL = 4, NP = 5760, NPROJ = 7168, DFF = 2816, IN_COLS = 7176;
constexpr int NTHREADS = 512, NWAVES = 8;
constexpr float EPS = 1e-6f;
constexpr int C_AQ = 0, C_AK = 512, C_AV = 640, C_IQ = 768, C_BG = 1280, C_CQ = 1792, C_IK = 2176, C_KPE = 2240, C_CKV = 2304, C_G = 2560;
constexpr int C_OA = C_AQ, C_OB = C_BG, C_OC = C_CQ;
constexpr int HT_Q = 0, HT_F = 1, HT_I = 2;

constexpr size_t MiB = 1u << 20;
constexpr size_t WS_CTL = 0, CTL_BYTES = 1 * MiB;
constexpr size_t WS_WIN = 1 * MiB;
constexpr size_t WS_WUP = WS_WIN + 14 * MiB;
constexpr size_t WS_WOUT = WS_WUP + 3 * MiB;
constexpr size_t WS_WQB = WS_WOUT + 2 * MiB;
constexpr size_t WS_WKVB = WS_WQB + 1 * MiB;
constexpr size_t WS_WGU = WS_WKVB + 1 * MiB;
constexpr size_t WS_WDN = WS_WGU + 11 * MiB;
constexpr size_t WS_SMALL = WS_WDN + 6 * MiB;
constexpr size_t WS_RSA = WS_SMALL + 2 * MiB;
constexpr size_t WS_RSF = WS_RSA + 1 * MiB;
constexpr size_t WS_COS = WS_RSF + 1 * MiB;
constexpr size_t WS_SIN = WS_COS + 2 * MiB;
constexpr size_t WS_KPE = WS_SIN + 2 * MiB;
constexpr size_t WS_MASK = WS_KPE + 2 * MiB;
constexpr size_t WS_X16 = WS_MASK + 4 * MiB;
constexpr size_t WS_QC = WS_X16 + 32 * MiB;
constexpr size_t WS_KN = WS_QC + 24 * MiB;
constexpr size_t WS_VCT = WS_KN + 16 * MiB;
constexpr size_t WS_MIX = WS_QC;
constexpr size_t WS_ST = WS_VCT + 16 * MiB;
constexpr size_t WS_HT = WS_ST + 32 * MiB;
constexpr size_t WS_AVT = WS_HT + 48 * MiB;
constexpr size_t WS_P = WS_AVT + 4 * MiB;
constexpr size_t WS_ACT = WS_P;
constexpr size_t WS_WDN2 = WS_P + 180 * MiB;
constexpr size_t WS_IKC = WS_WDN2 + 6 * MiB;
constexpr size_t WS_WGU2 = WS_IKC + 2 * MiB;
constexpr size_t WS_END = WS_WGU2 + 11 * MiB;
static_assert(WS_END <= 446 * MiB, "workspace map");
constexpr size_t SM_WIW = 0, SM_LB = 32768, SM_RSTDQ = 65536, SM_RSTDKV = 131072, SM_IW = 196608, SM_DC = 786432, SM_PMIN = 1572864, SM_PMAX = 1576960;

constexpr int LDS_MISC = 151552;
constexpr int LDS_BYTES = LDS_MISC + 1024;

#define VM_WAIT() asm volatile("s_waitcnt vmcnt(0)" ::: "memory")
#define LDS_WAIT() asm volatile("s_waitcnt lgkmcnt(0)" ::: "memory")

__device__ __forceinline__ unsigned pkh(float lo, float hi) { h16x2 v; v.x = (h16)lo; v.y = (h16)hi; return __builtin_bit_cast(unsigned, v); }
typedef float f32x2_t __attribute__((ext_vector_type(2)));
__device__ __forceinline__ u32x2 split_hl(float a, float b) { h16x2 h; h.x = (h16)a; h.y = (h16)b; const h16 hx = h.x, hy = h.y; u32x2 r; r.x = __builtin_bit_cast(unsigned, h); r.y = pkh(a - (float)hx, b - (float)hy); return r; }
__device__ __forceinline__ f32x2_t join_hl(unsigned hi, unsigned lo) { const h16x2 h = __builtin_bit_cast(h16x2, hi), l2 = __builtin_bit_cast(h16x2, lo); const h16 hx = h.x, hy = h.y, lx = l2.x, ly = l2.y; f32x2_t r; r.x = (float)hx + (float)lx; r.y = (float)hy + (float)ly; return r; }
__device__ __forceinline__ unsigned pkb(float lo, float hi) { unsigned r; asm volatile("v_cvt_pk_bf16_f32 %0, %1, %2" : "=v"(r) : "v"(lo), "v"(hi)); return r; }
__device__ __forceinline__ float bf2f(unsigned short b) { return __uint_as_float(((unsigned)b) << 16); }
__device__ __forceinline__ float wave_sum(float v) {
#pragma unroll
    for (int o = 1; o < 64; o <<= 1) v += __shfl_xor(v, o);
    return v;
}
__device__ __forceinline__ float sigmoidf_(float x) { return __builtin_amdgcn_rcpf(1.0f + __builtin_amdgcn_exp2f(-1.4426950408889634f * x)); }
__device__ __forceinline__ int crow(int r, int hi) { return (r & 3) + 8 * (r >> 2) + 4 * hi; }

#define XB_TMO      128
#define XB_XCNT(j)  (256  + 64 * (j))
#define XB_XSUB(j)  (1280 + 64 * (j))
#define XB_XGEN(j)  (2304 + 64 * (j))
#define XB_TOP      3328
#define XB_TOPGEN   3392
#define XCD_BAR_WORDS 3456
#define XB_SPIN_CAP (1u << 18)
__device__ __forceinline__ unsigned xb_ld(unsigned* p)              { return __hip_atomic_load(p, __ATOMIC_RELAXED, __HIP_MEMORY_SCOPE_AGENT); }
__device__ __forceinline__ unsigned xb_add(unsigned* p, unsigned v) { return __hip_atomic_fetch_add(p, v, __ATOMIC_RELAXED, __HIP_MEMORY_SCOPE_AGENT); }
__device__ __forceinline__ unsigned xb_xcc_id() { return (unsigned)__builtin_amdgcn_s_getreg((3 << 11) | 20) & 0xFu; }
#define XB_SPIN(cond, bar) do { unsigned _sp = 0; while (cond) { __builtin_amdgcn_s_sleep(1); \
    if ((++_sp & 255u) == 0u) { if (xb_ld(&(bar)[XB_TMO])) break; if (_sp > XB_SPIN_CAP) { atomicAdd(&(bar)[XB_TMO], 1u); break; } } } } while (0)
struct XcdBarrier { unsigned* bar; unsigned x; volatile LAS unsigned* st; };
__device__ __forceinline__ XcdBarrier xcd_barrier_post(unsigned* bar, volatile LAS unsigned* st) {
    XcdBarrier b; b.bar = bar; b.x = xb_xcc_id(); b.st = st;
    if (threadIdx.x == 0) (void)xb_add(&bar[XB_XCNT(b.x)], 1u);
    return b;
}
__device__ __forceinline__ void xcd_barrier_complete(unsigned* bar, unsigned x, unsigned& nloc, unsigned& nx) {
    const unsigned G = gridDim.x * gridDim.y * gridDim.z;
    unsigned sum, cnt, mine, sp = 0u;
    for (;;) {
        sum = 0u; cnt = 0u; mine = 0u;
#pragma unroll
        for (unsigned j = 0; j < 16; ++j) { const unsigned c = xb_ld(&bar[XB_XCNT(j)]); sum += c; cnt += (c > 0u) ? 1u : 0u; mine = (j == x) ? c : mine; }
        if (sum == G) break;
        __builtin_amdgcn_s_sleep(1);
        if ((++sp & 255u) == 0u) { if (xb_ld(&bar[XB_TMO])) break; if (sp > XB_SPIN_CAP) { atomicAdd(&bar[XB_TMO], 1u); break; } }
    }
    nloc = mine > 0u ? mine : 1u; nx = cnt > 0u ? cnt : 1u;
}
__device__ __forceinline__ void xcd_barrier(const XcdBarrier& b, bool leader) {
    asm volatile("s_waitcnt vmcnt(0)" ::: "memory");
    __syncthreads();
    if (leader) {
        unsigned* bar = b.bar;
        __builtin_amdgcn_s_waitcnt(0);
        unsigned nloc = b.st[0], nx = b.st[1];
        if (nloc == 0u) { xcd_barrier_complete(bar, b.x, nloc, nx); b.st[0] = nloc; b.st[1] = nx; }
        const unsigned old = xb_add(&bar[XB_XSUB(b.x)], 1u);
        const unsigned gen = old / nloc;
        if (old + 1u == (gen + 1u) * nloc) {
            __builtin_amdgcn_fence(__ATOMIC_RELEASE, "agent");
            asm volatile("s_waitcnt vmcnt(0)" ::: "memory");
            const unsigned og = xb_add(&bar[XB_TOP], 1u);
            const unsigned tg = og / nx;
            if (og + 1u == (tg + 1u) * nx) xb_add(&bar[XB_TOPGEN], 1u);
            else XB_SPIN(xb_ld(&bar[XB_TOPGEN]) == tg, bar);
            __builtin_amdgcn_fence(__ATOMIC_ACQUIRE, "agent");
            xb_add(&bar[XB_XGEN(b.x)], 1u);
            asm volatile("s_waitcnt vmcnt(0)" ::: "memory");
        } else {
            XB_SPIN(xb_ld(&bar[XB_XGEN(b.x)]) == gen, bar);
            __builtin_amdgcn_fence(__ATOMIC_ACQUIRE, "agent");
            asm volatile("s_waitcnt vmcnt(0)" ::: "memory");
        }
    }
    __syncthreads();
}

__device__ __forceinline__ int lane_id() { return (int)__builtin_amdgcn_mbcnt_hi(~0u, __builtin_amdgcn_mbcnt_lo(~0u, 0u)); }
#ifdef PROBE_SEL
__device__ __noinline__ void stamp_call(volatile LAS unsigned* st, int kind, int who) {
    if (who == 0 && lane_id() == 0) { const unsigned long long now_ = __builtin_amdgcn_s_memrealtime(); volatile LAS unsigned long long* T_ = (volatile LAS unsigned long long*)(st + 56); T_[1 + kind] += now_ - T_[0]; T_[0] = now_; } }
#endif
__device__ __noinline__ void xcd_barrier_call(unsigned* barw, unsigned x, volatile LAS unsigned* st, int wave, int kind, int who) {
#ifdef PROBE_SEL
    if (who == 0 && lane_id() == 0) { const unsigned long long now_ = __builtin_amdgcn_s_memrealtime(); volatile LAS unsigned long long* T_ = (volatile LAS unsigned long long*)(st + 56); T_[1 + kind] += now_ - T_[0]; T_[0] = now_; }
#endif
    XcdBarrier b; b.bar = barw; b.x = x; b.st = st; xcd_barrier(b, wave == 0 && lane_id() == 0);
#ifdef PROBE_SEL
    if (who == 0 && lane_id() == 0) { const unsigned long long now_ = __builtin_amdgcn_s_memrealtime(); volatile LAS unsigned long long* T_ = (volatile LAS unsigned long long*)(st + 56); T_[17] += now_ - T_[0]; T_[0] = now_; }
#endif
}
namespace pg8 {
constexpr int BM = 256, BK = 64, HALF = 128, HTB = HALF * BK * 2, STAGE_BYTES = 8 * HTB, NXCD = 8, WGM = 8;
__host__ __device__ __forceinline__ int lds_byte(int r, int c) { const int st = (r >> 4) * 2 + (c >> 5), rr = r & 15, cc = c & 31, ob = rr * 64 + cc * 2; return st * 1024 + (ob ^ (((ob >> 9) & 1) << 5)); }
__host__ __device__ __forceinline__ void stage_rc(int b, int& R, int& C) { const int st = b / 1024, sb = b % 1024, swz = sb ^ (((sb >> 9) & 1) << 5); R = (st >> 1) * 16 + swz / 64; C = (st & 1) * 32 + (swz % 64) / 2; }
__host__ __device__ __forceinline__ int perm32(int rho) { const int n = rho >> 4, i = rho & 15; return 8 * (i >> 2) + 4 * n + (i & 3); }

struct Unit { const char* A; const char* B; int pm, pn, br; };
struct TileOrder {
    int nM, nN, nwg, G, c, nbr;
    __device__ __forceinline__ void init(int M_, int N_, int G_, int c_, int nbr_ = 1) { nM = M_ / BM; nN = N_ / BM; nwg = nM * nN; G = G_; c = c_; nbr = nbr_; }
    __device__ __forceinline__ bool tile(int i, int& pm, int& pn, int& br) const {
        const int it = i / nbr; br = i - it * nbr;
        const long L = (long)it * G + c; if (L >= nwg) return false;
        int wgid = (int)L; { const int q = nwg / NXCD, r = nwg % NXCD, xcd = wgid % NXCD, off = wgid / NXCD; wgid = (xcd < r ? xcd * (q + 1) : r * (q + 1) + (xcd - r) * q) + off; }
        const int nig = WGM * nN, gid = wgid / nig, fm = gid * WGM, gsz = (nM - fm) < WGM ? (nM - fm) : WGM;
        pm = fm + ((wgid % nig) % gsz); pn = (wgid % nig) / gsz; return true;
    }
};
struct PlainSched {
    TileOrder T; const char* A; const char* B; size_t lda2, ldb2;
    __device__ __forceinline__ bool next(int i, Unit& u) const { int pm, pn, br; if (!T.tile(i, pm, pn, br)) return false; u.pm = pm; u.pn = pn; u.br = br; u.A = A + (size_t)pm * BM * lda2; u.B = B + (size_t)pn * BM * ldb2; return true; }
    static __device__ __forceinline__ size_t aoff(int t) { return (size_t)t * 128; }
};
struct Cat3Sched {
    TileOrder T; const char* A; const char* B; size_t lda2, ldb2;
    __device__ __forceinline__ bool next(int i, Unit& u) const { int pm, pn, br; if (!T.tile(i, pm, pn, br)) return false; u.pm = pm; u.pn = pn; u.br = br; u.A = A + (size_t)pm * BM * lda2; u.B = B + (size_t)pn * BM * ldb2; return true; }
    static __device__ __forceinline__ size_t aoff(int t) { const int br = t >> 3; return (size_t)((t & 7) * 128 + (br == 0 ? C_OA * 2 : (br == 1 ? C_OB * 2 : C_OC * 2))); }
};
template <class Epi, class Sched>
__device__ __forceinline__ void gemm_phase(LAS unsigned char* lds, const int tid_in, const int K, const size_t lda2, const size_t ldb2, const Sched& S, const Epi& E) {
    int tid = tid_in; asm volatile("" : "+v"(tid));
    const int wid = __builtin_amdgcn_readfirstlane(tid >> 6), lane = tid & 63, wr = wid >> 2, wc = wid & 3, fr = lane & 15, fq = lane >> 4;
    int nt = K / BK; asm volatile("" : "+s"(nt));
    unsigned voffA[2], voffB[2];
#pragma unroll
    for (int i = 0; i < 2; ++i) { int R, C; stage_rc(tid * 16 + i * 8192, R, C); const int Rb = Epi::PERM ? ((R & ~31) + perm32(R & 31)) : R;
        voffA[i] = (unsigned)((size_t)R * lda2 + C * 2); voffB[i] = (unsigned)((size_t)Rb * ldb2 + C * 2); }
    const size_t hstepA = (size_t)HALF * lda2, hstepB = (size_t)HALF * ldb2;
    const unsigned ldsw = (unsigned)wid * 1024u;
    const int aoff = lds_byte(wr * 64 + fr, fq * 8), boff = lds_byte(wc * 32 + fr, fq * 8);
#ifndef REP_MASK
#define REP_MASK 0
#endif
#define PG8_SA(b, h) (((b) * 2 + (h)) * HTB)
#define PG8_SB(b, h) ((4 + (b) * 2 + (h)) * HTB)
#define PG8_STAGE(bufoff, gbase, voff) do { _Pragma("unroll") for (int _i = 0; _i < 2; ++_i) \
        __builtin_amdgcn_global_load_lds((const unsigned*)((const char*)(gbase) + (voff)[_i]), (LAS unsigned*)(lds + (bufoff) + ldsw + _i * 8192), 16, 0, 0); } while (0)
#define PG8_LDA(dst, b, h) do { _Pragma("unroll") for (int m = 0; m < 4; ++m) _Pragma("unroll") for (int k = 0; k < 2; ++k) dst[m][k] = *(const LAS h16x8*)(lds + PG8_SA(b, h) + aoff + m * 2048 + k * 1024); } while (0)
#define PG8_LDB(dst, b, h) do { _Pragma("unroll") for (int n = 0; n < 2; ++n) _Pragma("unroll") for (int k = 0; k < 2; ++k) dst[n][k] = *(const LAS h16x8*)(lds + PG8_SB(b, h) + boff + n * 2048 + k * 1024); } while (0)
#define PG8_MMA(ai, bj, At, Bt) do { __builtin_amdgcn_s_setprio(1); _Pragma("unroll") for (int m = 0; m < 4; ++m) _Pragma("unroll") for (int n = 0; n < 2; ++n) _Pragma("unroll") for (int k = 0; k < 2; ++k) \
        acc[ai][bj][m][n] = __builtin_amdgcn_mfma_f32_16x16x32_f16(Bt[n][k], At[m][k], acc[ai][bj][m][n], 0, 0, 0); __builtin_amdgcn_s_setprio(0); } while (0)
#define PG8_WAIT_V(n) asm volatile("s_waitcnt vmcnt(" #n ")" ::: "memory")
#define PG8_WAIT_L(n) asm volatile("s_waitcnt lgkmcnt(" #n ")" ::: "memory")
#define PG8_BAR __builtin_amdgcn_s_barrier()
#define PG8_SCHED __builtin_amdgcn_sched_barrier(0)
    Unit cur, nxt; int ui = 0;
    if (!S.next(0, cur)) return;
    f32x4 acc[2][2][4][2];
#pragma unroll
    for (int a = 0; a < 2; ++a)
#pragma unroll
        for (int b = 0; b < 2; ++b)
#pragma unroll
            for (int m = 0; m < 4; ++m)
#pragma unroll
                for (int n = 0; n < 2; ++n) acc[a][b][m][n] = (f32x4){0.f, 0.f, 0.f, 0.f};
    h16x8 At[4][2], B0[2][2], B1[2][2];
    const char* cA = cur.A; const char* cB = cur.B;
    PG8_STAGE(PG8_SB(0, 0), cB, voffB); PG8_STAGE(PG8_SB(0, 1), cB + hstepB, voffB); PG8_STAGE(PG8_SA(0, 0), cA + Sched::aoff(0), voffA); PG8_STAGE(PG8_SA(0, 1), cA + Sched::aoff(0) + hstepA, voffA);
    if (wr == 1) PG8_BAR;
    PG8_WAIT_V(2); PG8_BAR;
    PG8_STAGE(PG8_SB(1, 0), cB + 128, voffB); PG8_STAGE(PG8_SA(1, 0), cA + Sched::aoff(1), voffA); PG8_STAGE(PG8_SB(1, 1), cB + hstepB + 128, voffB);
    PG8_WAIT_V(6); PG8_BAR;
    for (;;) {
        const bool has_next = S.next(ui + 1, nxt);
        const char* nA = has_next ? nxt.A : cA; const char* nB = has_next ? nxt.B : cB;
        for (int t = 0; t < nt; t += 2) {
            const bool last = (t == nt - 2);
            if constexpr (Epi::MID) if (t == 8 || t == 16) { unsigned z_ = 0u; asm volatile("" : "+v"(z_)); const int le = (int)__builtin_amdgcn_mbcnt_hi(~0u, __builtin_amdgcn_mbcnt_lo(~0u, z_));
                E.mid(acc, cur, wr, wc, le & 15, le >> 4, t >> 3); }
            const char* a1 = cA + Sched::aoff(t + 1);
            const char* a2 = last ? nA + Sched::aoff(0) : cA + Sched::aoff(t + 2); const char* b2 = last ? nB : cB + (size_t)(t + 2) * 128;
            const char* a3 = last ? nA + Sched::aoff(1) : cA + Sched::aoff(t + 3); const char* b3 = b2 + 128;
            PG8_LDB(B0, 0, 0); PG8_LDB(B1, 0, 1); PG8_SCHED; PG8_LDA(At, 0, 0); PG8_STAGE(PG8_SA(1, 1), a1 + hstepA, voffA);
            PG8_WAIT_V(8); PG8_WAIT_L(0); PG8_BAR; PG8_MMA(0, 0, At, B0); PG8_MMA(0, 1, At, B1); PG8_BAR; PG8_SCHED;
            PG8_LDA(At, 0, 1); PG8_STAGE(PG8_SB(0, 0), b2, voffB); PG8_STAGE(PG8_SB(0, 1), b2 + hstepB, voffB); PG8_STAGE(PG8_SA(0, 0), a2, voffA);
            PG8_WAIT_V(8); PG8_WAIT_L(0); PG8_BAR; PG8_MMA(1, 0, At, B0); PG8_MMA(1, 1, At, B1); PG8_BAR; PG8_SCHED;
            PG8_LDB(B0, 1, 0); PG8_LDB(B1, 1, 1); PG8_SCHED; PG8_LDA(At, 1, 0); PG8_STAGE(PG8_SA(0, 1), a2 + hstepA, voffA);
            PG8_WAIT_V(8); PG8_WAIT_L(0); PG8_BAR; PG8_MMA(0, 0, At, B0); PG8_MMA(0, 1, At, B1); PG8_BAR; PG8_SCHED;
            PG8_LDA(At, 1, 1); PG8_STAGE(PG8_SB(1, 0), b3, voffB); PG8_STAGE(PG8_SB(1, 1), b3 + hstepB, voffB); PG8_STAGE(PG8_SA(1, 0), a3, voffA);
            PG8_WAIT_V(8); PG8_WAIT_L(0); PG8_BAR; PG8_MMA(1, 0, At, B0); PG8_MMA(1, 1, At, B1); PG8_BAR; PG8_SCHED;
        }
        if (wr == 0) PG8_BAR;
        { unsigned z_ = 0u; asm volatile("" : "+v"(z_)); const int le = (int)__builtin_amdgcn_mbcnt_hi(~0u, __builtin_amdgcn_mbcnt_lo(~0u, z_));
          E(acc, cur, wr, wc, le & 15, le >> 4);
          if (((REP_MASK >> 16) & 1) && Epi::IDEMP) E(acc, cur, wr, wc, le & 15, le >> 4); }
        if (!has_next) break;
#pragma unroll
        for (int a = 0; a < 2; ++a)
#pragma unroll
            for (int b = 0; b < 2; ++b)
#pragma unroll
                for (int m = 0; m < 4; ++m)
#pragma unroll
                    for (int n = 0; n < 2; ++n) acc[a][b][m][n] = (f32x4){0.f, 0.f, 0.f, 0.f};
        cur = nxt; cA = nA; cB = nB; ++ui;
        if (wr == 1) PG8_BAR;
    }
    PG8_WAIT_V(0);
    PG8_BAR;
#undef PG8_SA
#undef PG8_SB
#undef PG8_STAGE
#undef PG8_LDA
#undef PG8_LDB
#undef PG8_MMA
#undef PG8_WAIT_V
#undef PG8_WAIT_L
#undef PG8_BAR
#undef PG8_SCHED
}

__device__ __forceinline__ float rstd_from_parts(const float* part, int row, float inv_n) {
    const f32x4* p = (const f32x4*)(part + (size_t)row * 16);
    const f32x4 a = p[0], b = p[1], c = p[2], d = p[3];
    const float s = ((a[0] + a[1]) + (a[2] + a[3])) + ((b[0] + b[1]) + (b[2] + b[3])) + ((c[0] + c[1]) + (c[2] + c[3])) + ((d[0] + d[1]) + (d[2] + d[3]));
    return __builtin_amdgcn_rsqf(s * inv_n + EPS);
}
__device__ __forceinline__ void store_tr8(h16* T, int ncols, int m, int c, const f32x4& v0, const f32x4& v1) {
    h16* p = T + ((size_t)(m >> 11) * ncols + c) * SEQ + (m & (SEQ - 1));
    p[0 * SEQ] = (h16)v0[0]; p[1 * SEQ] = (h16)v0[1]; p[2 * SEQ] = (h16)v0[2]; p[3 * SEQ] = (h16)v0[3];
    p[4 * SEQ] = (h16)v1[0]; p[5 * SEQ] = (h16)v1[1]; p[6 * SEQ] = (h16)v1[2]; p[7 * SEQ] = (h16)v1[3];
}
struct EpiScaleParts {
    static constexpr bool PERM = true; static constexpr bool MID = true; static constexpr bool IDEMP = true;
    h16* O; int ldc; const float* part; h16* HT; h16* AVT; h16* IKC; LAS unsigned char* tab;
    __device__ __forceinline__ void mid(f32x4 (&)[2][2][4][2], const Unit& u, int wr, int wc, int fr, int fq, int brn) const {
        if (brn == 1) { const int wid = wr * 4 + wc, lane = fq * 16 + fr; const float* src = part + (size_t)u.pm * BM * 16 + (wid * 64 + lane) * 4;
#pragma unroll
            for (int i = 0; i < 2; ++i) __builtin_amdgcn_global_load_lds((const unsigned*)(src + i * 2048), (LAS unsigned*)(tab + i * 8192 + wid * 1024), 16, 0, 0); }
    }
    __device__ __forceinline__ void operator()(const f32x4 (&acc)[2][2][4][2], const Unit& u, int wr, int wc, int fr, int fq) const {
        const int row0 = u.pm * BM + wr * 64 + fr, col0 = u.pn * BM + wc * 32 + 8 * fq;
        const LAS unsigned char* trow = tab + (wr * 64 + fr) * 64;
        const bool tr = u.pn >= 22;
        h16* Tk = HT + (size_t)((u.pn - 22) >> 1) * ((size_t)NB * 512 * SEQ); const int tc0 = ((u.pn - 22) & 1) * 256 + wc * 32 + 8 * fq;
#pragma unroll
        for (int g = 0; g < 8; ++g) { const int ai = g >> 2, m = g & 3; const int row = row0 + ai * HALF + m * 16;
            const LAS f32x4* tp = (const LAS f32x4*)(trow + (ai * HALF + m * 16) * 64);
            const f32x4 a = tp[0], bq = tp[1], c = tp[2], d = tp[3];
            const float s = ((a[0] + a[1]) + (a[2] + a[3])) + ((bq[0] + bq[1]) + (bq[2] + bq[3])) + ((c[0] + c[1]) + (c[2] + c[3])) + ((d[0] + d[1]) + (d[2] + d[3]));
            const float rs = __builtin_amdgcn_rsqf(s * (1.0f / 1024.0f) + EPS);
            h16* rowp = O + (size_t)row * ldc + col0;
#pragma unroll
            for (int bj = 0; bj < 2; ++bj) { const f32x4 v0 = acc[ai][bj][m][0] * rs, v1 = acc[ai][bj][m][1] * rs;
                if (tr) store_tr8(Tk, 512, row, tc0 + bj * HALF, v0, v1);
                else { u32x4 w; w.x = pkh(v0[0], v0[1]); w.y = pkh(v0[2], v0[3]); w.z = pkh(v1[0], v1[1]); w.w = pkh(v1[2], v1[3]);
                    *(u32x4*)(rowp + bj * HALF) = w;
                    if (bj == 1 && u.pn == 2) store_tr8(AVT, 128, row, wc * 32 + 8 * fq, v0, v1);
                    if (bj == 1 && u.pn == 8 && wc < 2) *(u32x4*)(IKC + (size_t)row * 64 + wc * 32 + 8 * fq) = w; } } }
    }
};
struct EpiKV {
    static constexpr bool PERM = true; static constexpr bool MID = false; static constexpr bool IDEMP = true;
    h16* KN; h16* VCT; const float* rstd;
    __device__ __forceinline__ void operator()(const f32x4 (&acc)[2][2][4][2], const Unit& u, int wr, int wc, int fr, int fq) const {
        const int row0 = u.pm * BM + wr * 64 + fr, c8 = wc * 32 + 8 * fq;
#pragma unroll
        for (int ai = 0; ai < 2; ++ai)
#pragma unroll
            for (int m = 0; m < 4; ++m) { const int row = row0 + ai * HALF + m * 16; const float rs = rstd[row];
                { const f32x4 v0 = acc[ai][0][m][0] * rs, v1 = acc[ai][0][m][1] * rs;
                  u32x4 w; w.x = pkh(v0[0], v0[1]); w.y = pkh(v0[2], v0[3]); w.z = pkh(v1[0], v1[1]); w.w = pkh(v1[2], v1[3]);
                  *(u32x4*)(KN + (size_t)row * 512 + u.pn * 128 + c8) = w; }
                { const f32x4 v0 = acc[ai][1][m][0] * rs, v1 = acc[ai][1][m][1] * rs;
                  store_tr8(VCT + (size_t)u.pn * 128 * SEQ, 512, row, c8, v0, v1); }
                asm volatile("" ::: "memory"); }
    }
};
struct EpiPlainDummy {
    static constexpr bool PERM = true; static constexpr bool MID = false; static constexpr bool IDEMP = true;
    h16* O; int ldc;
    __device__ __forceinline__ void operator()(const f32x4 (&acc)[2][2][4][2], const Unit& u, int wr, int wc, int fr, int fq) const {
        const int row0 = u.pm * BM + wr * 64 + fr, col0 = u.pn * BM + wc * 32 + 8 * fq;
#pragma unroll
        for (int ai = 0; ai < 2; ++ai)
#pragma unroll
            for (int m = 0; m < 4; ++m) { const int row = (row0 + ai * HALF + m * 16) & 1023; h16* rowp = O + (size_t)row * ldc + col0;
#pragma unroll
                for (int bj = 0; bj < 2; ++bj) { const f32x4 v0 = acc[ai][bj][m][0], v1 = acc[ai][bj][m][1];
                    u32x4 w; w.x = pkh(v0[0], v0[1]); w.y = pkh(v0[2], v0[3]); w.z = pkh(v1[0], v1[1]); w.w = pkh(v1[2], v1[3]);
                    *(u32x4*)(rowp + bj * HALF) = w; } }
    }
};
template <bool ROPE> struct EpiScaleRow {
    static constexpr bool PERM = true; static constexpr bool MID = false; static constexpr bool IDEMP = true;
    h16* O; int ldc; const float* rstd; const float* cosT; const float* sinT;
    __device__ __forceinline__ void operator()(const f32x4 (&acc)[2][2][4][2], const Unit& u, int wr, int wc, int fr, int fq) const {
        const int row0 = u.pm * BM + wr * 64 + fr, col0 = u.pn * BM + wc * 32 + 8 * fq;
#pragma unroll
        for (int ai = 0; ai < 2; ++ai)
#pragma unroll
            for (int m = 0; m < 4; ++m) { const int row = row0 + ai * HALF + m * 16; const float rs = rstd[row];
                h16* rowp = O + (size_t)row * ldc + col0;
#pragma unroll
                for (int bj = 0; bj < 2; ++bj) { f32x4 v0 = acc[ai][bj][m][0] * rs, v1 = acc[ai][bj][m][1] * rs;
                    if (ROPE) { const int c = col0 + bj * HALF, cm = c % 192;
                        if (cm >= 128) { const int i0 = (cm - 128) >> 1;
                            const f32x4 cs = *(const f32x4*)(cosT + (size_t)row * 32 + i0), sn = *(const f32x4*)(sinT + (size_t)row * 32 + i0);
                            const f32x4 a = v0, b = v1;
                            v0[0] = a[0] * cs[0] - a[1] * sn[0]; v0[1] = a[1] * cs[0] + a[0] * sn[0];
                            v0[2] = a[2] * cs[1] - a[3] * sn[1]; v0[3] = a[3] * cs[1] + a[2] * sn[1];
                            v1[0] = b[0] * cs[2] - b[1] * sn[2]; v1[1] = b[1] * cs[2] + b[0] * sn[2];
                            v1[2] = b[2] * cs[3] - b[3] * sn[3]; v1[3] = b[3] * cs[3] + b[2] * sn[3]; } }
                    u32x4 w; w.x = pkh(v0[0], v0[1]); w.y = pkh(v0[2], v0[3]); w.z = pkh(v1[0], v1[1]); w.w = pkh(v1[2], v1[3]);
                    *(u32x4*)(rowp + bj * HALF) = w; }
                asm volatile("" ::: "memory"); }
    }
};
struct EpiGate3 {
    static constexpr bool PERM = true; static constexpr bool IDEMP = true; static constexpr bool MID = true;
    h16* O; const h16* G; int ldg;
    __device__ __forceinline__ void mid(f32x4 (&acc)[2][2][4][2], const Unit& u, int wr, int wc, int fr, int fq, int brn) const {
        const int row0 = u.pm * BM + wr * 64 + fr, col0 = u.pn * BM + wc * 32 + 8 * fq;
        const h16* gbase = G + (size_t)row0 * ldg + col0 + (brn - 1) * 1024;
        h16x8 gb[2][2][4];
#define G3_LOAD(buf, pr) do { _Pragma("unroll") for (int s_ = 0; s_ < 2; ++s_) { const int g_ = 2 * (pr) + s_; const h16* gp_ = gbase + (size_t)((g_ >> 2) * HALF + (g_ & 3) * 16) * ldg; \
            gb[buf][s_][0] = *(const h16x8*)gp_; gb[buf][s_][1] = *(const h16x8*)(gp_ + HALF); gb[buf][s_][2] = *(const h16x8*)(gp_ + 1024); gb[buf][s_][3] = *(const h16x8*)(gp_ + 1024 + HALF); } } while (0)
        G3_LOAD(0, 0);
#pragma unroll
        for (int pr = 0; pr < 4; ++pr) {
            if (pr + 1 < 4) G3_LOAD((pr + 1) & 1, pr + 1);
            __builtin_amdgcn_sched_barrier(0);
#pragma unroll
            for (int s = 0; s < 2; ++s) { const int g = 2 * pr + s, ai = g >> 2, m = g & 3;
#pragma unroll
                for (int bj = 0; bj < 2; ++bj) { const h16x8 gx = gb[pr & 1][s][bj], gy = gb[pr & 1][s][2 + bj];
#pragma unroll
                    for (int j = 0; j < 4; ++j) {
                        acc[ai][bj][m][0][j] *= (1.0f + __builtin_amdgcn_exp2f(-1.4426950408889634f * (float)gy[j])) * __builtin_amdgcn_rcpf(1.0f + __builtin_amdgcn_exp2f(-1.4426950408889634f * (float)gx[j]));
                        acc[ai][bj][m][1][j] *= (1.0f + __builtin_amdgcn_exp2f(-1.4426950408889634f * (float)gy[4 + j])) * __builtin_amdgcn_rcpf(1.0f + __builtin_amdgcn_exp2f(-1.4426950408889634f * (float)gx[4 + j])); } } }
            __builtin_amdgcn_sched_barrier(0); }
#undef G3_LOAD
    }
    __device__ __forceinline__ void operator()(const f32x4 (&acc)[2][2][4][2], const Unit& u, int wr, int wc, int fr, int fq) const {
        const int row0 = u.pm * BM + wr * 64 + fr, col0 = u.pn * BM + wc * 32 + 8 * fq;
        const h16* gbase = G + (size_t)row0 * ldg + 2048 + col0;
        h16x8 gb[2][2][2];
#define G3_LOAD(buf, pr) do { _Pragma("unroll") for (int s_ = 0; s_ < 2; ++s_) { const int g_ = 2 * (pr) + s_; const h16* gp_ = gbase + (size_t)((g_ >> 2) * HALF + (g_ & 3) * 16) * ldg; \
            gb[buf][s_][0] = *(const h16x8*)gp_; gb[buf][s_][1] = *(const h16x8*)(gp_ + HALF); } } while (0)
        G3_LOAD(0, 0);
#pragma unroll
        for (int pr = 0; pr < 4; ++pr) {
            if (pr + 1 < 4) G3_LOAD((pr + 1) & 1, pr + 1);
            __builtin_amdgcn_sched_barrier(0);
#pragma unroll
            for (int s = 0; s < 2; ++s) { const int g = 2 * pr + s, ai = g >> 2, m = g & 3; const int row = row0 + ai * HALF + m * 16; h16* rowp = O + (size_t)row * 1024 + col0;
#pragma unroll
                for (int bj = 0; bj < 2; ++bj) { const h16x8 g8 = gb[pr & 1][s][bj];
                    f32x4 v0 = acc[ai][bj][m][0], v1 = acc[ai][bj][m][1];
#pragma unroll
                    for (int j = 0; j < 4; ++j) { v0[j] *= sigmoidf_((float)g8[j]); v1[j] *= sigmoidf_((float)g8[4 + j]); }
                    u32x4 w; w.x = pkh(v0[0], v0[1]); w.y = pkh(v0[2], v0[3]); w.z = pkh(v1[0], v1[1]); w.w = pkh(v1[2], v1[3]);
                    *(u32x4*)(rowp + bj * HALF) = w; } }
            __builtin_amdgcn_sched_barrier(0); }
#undef G3_LOAD
    }
};
struct EpiResidual {
    static constexpr bool PERM = true; static constexpr bool MID = false; static constexpr bool PRE = false; static constexpr bool IDEMP = false;
    h16* X16; float* part;
    __device__ __forceinline__ void operator()(const f32x4 (&acc)[2][2][4][2], const Unit& u, int wr, int wc, int fr, int fq) const {
        const int row0 = u.pm * BM + wr * 64 + fr, col0 = u.pn * BM + wc * 32 + 8 * fq;
        h16x8 bh[4][2];
#define RES_LOAD(slot, g_) do { const size_t o_ = (size_t)(row0 + ((g_) >> 2) * HALF + ((g_) & 3) * 16) * 1024 + col0; _Pragma("unroll") for (int bj_ = 0; bj_ < 2; ++bj_) bh[slot][bj_] = *(const h16x8*)(X16 + o_ + bj_ * HALF); } while (0)
        RES_LOAD(0, 0); RES_LOAD(1, 1); RES_LOAD(2, 2);
#pragma unroll
        for (int g = 0; g < 8; ++g) { const int ai = g >> 2, m = g & 3; const int row = row0 + ai * HALF + m * 16; const size_t off = (size_t)row * 1024 + col0; float ss = 0.f;
            if (g + 3 < 8) RES_LOAD((g + 3) & 3, g + 3);
#pragma unroll
            for (int bj = 0; bj < 2; ++bj) { const h16x8 hv = bh[g & 3][bj];
                f32x4 o0, o1; o0[0] = (float)hv[0]; o0[1] = (float)hv[1]; o0[2] = (float)hv[2]; o0[3] = (float)hv[3]; o1[0] = (float)hv[4]; o1[1] = (float)hv[5]; o1[2] = (float)hv[6]; o1[3] = (float)hv[7];
                o0 += acc[ai][bj][m][0]; o1 += acc[ai][bj][m][1];
                ss += ((o0[0] * o0[0] + o0[1] * o0[1]) + (o0[2] * o0[2] + o0[3] * o0[3])) + ((o1[0] * o1[0] + o1[1] * o1[1]) + (o1[2] * o1[2] + o1[3] * o1[3]));
                u32x4 wh; wh.x = pkh(o0[0], o0[1]); wh.y = pkh(o0[2], o0[3]); wh.z = pkh(o1[0], o1[1]); wh.w = pkh(o1[2], o1[3]);
                *(u32x4*)(X16 + off + bj * HALF) = wh; }
            ss += __shfl_xor(ss, 16); ss += __shfl_xor(ss, 32);
            if (fq == 0) part[(size_t)row * 16 + u.pn * 4 + wc] = ss; }
#undef RES_LOAD
    }
};
struct EpiSwiGLU {
    static constexpr bool PERM = true; static constexpr bool MID = true; static constexpr bool IDEMP = true;
    h16* O; const float* part; LAS unsigned char* tab;
    __device__ __forceinline__ void mid(f32x4 (&)[2][2][4][2], const Unit& u, int wr, int wc, int fr, int fq, int brn) const {
        if (brn == 1) { const int wid = wr * 4 + wc, lane = fq * 16 + fr; const float* src = part + (size_t)u.pm * BM * 16 + (wid * 64 + lane) * 4;
#pragma unroll
            for (int i = 0; i < 2; ++i) __builtin_amdgcn_global_load_lds((const unsigned*)(src + i * 2048), (LAS unsigned*)(tab + i * 8192 + wid * 1024), 16, 0, 0); }
    }
    __device__ __forceinline__ void operator()(const f32x4 (&acc)[2][2][4][2], const Unit& u, int wr, int wc, int fr, int fq) const {
        const int row0 = u.pm * BM + wr * 64 + fr, col0 = u.pn * HALF + wc * 32 + 8 * fq;
        const LAS unsigned char* trow = tab + (wr * 64 + fr) * 64;
#pragma unroll
        for (int g = 0; g < 8; ++g) { const int ai = g >> 2, m = g & 3; const int row = row0 + ai * HALF + m * 16;
            const LAS f32x4* tp = (const LAS f32x4*)(trow + (ai * HALF + m * 16) * 64);
            const f32x4 a = tp[0], bq = tp[1], c = tp[2], d = tp[3];
            const float s = ((a[0] + a[1]) + (a[2] + a[3])) + ((bq[0] + bq[1]) + (bq[2] + bq[3])) + ((c[0] + c[1]) + (c[2] + c[3])) + ((d[0] + d[1]) + (d[2] + d[3]));
            const float rs = __builtin_amdgcn_rsqf(s * (1.0f / 1024.0f) + EPS);
            float o[8];
#pragma unroll
            for (int n = 0; n < 2; ++n)
#pragma unroll
                for (int j = 0; j < 4; ++j) { const float gt = acc[ai][0][m][n][j] * rs, up = acc[ai][1][m][n][j] * rs; o[n * 4 + j] = gt * sigmoidf_(gt) * up; }
            u32x4 w; w.x = pkh(o[0], o[1]); w.y = pkh(o[2], o[3]); w.z = pkh(o[4], o[5]); w.w = pkh(o[6], o[7]);
            *(u32x4*)(O + (size_t)row * DFF + col0) = w; }
    }
};
}
struct Args { const float* in[20]; float* out; unsigned char* ws; int ph_lo, ph_hi; };
struct Frame {
    LAS unsigned char* lds;
    int tid, lane, wave, G, bid;
    unsigned char* ws;
    float* out;
};
__device__ __forceinline__ const float* arg_in(LAS unsigned char* lds, int i) { const u32x2 v = *(const LAS u32x2*)(lds + LDS_MISC + 512 + 8 * i);
    const unsigned long long p = ((unsigned long long)(unsigned)__builtin_amdgcn_readfirstlane((int)v.y) << 32) | (unsigned)__builtin_amdgcn_readfirstlane((int)v.x); return (const float*)(const __attribute__((address_space(1))) float*)p; }
#define FIN(i) (arg_in(F.lds, (i)))
enum { I_X = 0, I_POS, I_WIN, I_WUPA, I_WUPB, I_WUPC, I_WOUT, I_QNORM, I_WQB, I_KVNORM, I_WKVB, I_LBLOG, I_ONORM, I_RELB, I_ANORM, I_FNORM, I_WFG, I_WFU, I_WFD, I_FINAL };

template <class ColMap>
__device__ __forceinline__ void transpose_item(const float* W, int ldw, int K, h16* WT, const float* gain, LAS float* scr, int item, int nblk, int lane, const ColMap& cm, int ldo = 0) {
    if (ldo == 0) ldo = K;
    const int kb = item / nblk, nb = item % nblk, k0 = 64 * kb, n0 = 32 * nb;
    const int sc = cm(n0 + (lane & 31));
    float wv[32];
#pragma unroll
    for (int i = 0; i < 32; ++i) wv[i] = W[(size_t)(k0 + 2 * i + (lane >> 5)) * ldw + sc];
    if (gain) {
#pragma unroll
        for (int i = 0; i < 32; ++i) wv[i] *= gain[k0 + 2 * i + (lane >> 5)]; }
#pragma unroll
    for (int i = 0; i < 32; ++i) scr[(2 * i + (lane >> 5)) * 33 + (lane & 31)] = wv[i];
    LDS_WAIT(); asm volatile("" ::: "memory");
    const int c = lane & 7;
#pragma unroll
    for (int j = 0; j < 4; ++j) { const int n = (lane >> 3) + 8 * j; const LAS float* s = scr + (8 * c) * 33 + n;
        u32x4 o; o.x = pkh(s[0 * 33], s[1 * 33]); o.y = pkh(s[2 * 33], s[3 * 33]); o.z = pkh(s[4 * 33], s[5 * 33]); o.w = pkh(s[6 * 33], s[7 * 33]);
        *(u32x4*)(WT + (size_t)(n0 + n) * ldo + k0 + 8 * c) = o; }
    LDS_WAIT(); asm volatile("" ::: "memory");
}
struct MapIn { __device__ int operator()(int n) const {
        if (n < 1280) return n;
        if (n < 1792) return 2888 + (n - 1280);
        if (n < 2176) return 3400 + (n - 1792);
        if (n < 2240) return 1280 + (n - 2176);
        if (n < 2304) { const int p = n - 2240; return 4040 + ((p & 1) * 32 + (p >> 1)); }
        if (n < 2560) return 3784 + (n - 2304);
        if (n < 5632) return 4104 + (n - 2560);
        if (n < 6144) return 1352 + (n - 5632);
        if (n < 6656) return 1864 + (n - 6144);
        return 2376 + (n - 6656); } };
struct MapId { __device__ int operator()(int n) const { return n; } };
struct MapQb { __device__ int operator()(int n) const { const int h = n / 192, d = n % 192; if (d < 128) return n; const int p = d - 128; return h * 192 + 128 + ((p & 1) * 32 + (p >> 1)); } };
struct MapGU { __device__ int operator()(int n) const { const int u = n >> 8, w = n & 255; return 128 * u + (w & 127); } };

__device__ __forceinline__ int wave_max_i(int v) {
    v = max(v, __builtin_amdgcn_update_dpp(v, v, 0xB1, 0xF, 0xF, false));
    v = max(v, __builtin_amdgcn_update_dpp(v, v, 0x4E, 0xF, 0xF, false));
    v = max(v, __builtin_amdgcn_update_dpp(v, v, 0x141, 0xF, 0xF, false));
    v = max(v, __builtin_amdgcn_update_dpp(v, v, 0x140, 0xF, 0xF, false));
    return max(max(__builtin_amdgcn_readlane(v, 0), __builtin_amdgcn_readlane(v, 16)), max(__builtin_amdgcn_readlane(v, 32), __builtin_amdgcn_readlane(v, 48)));
}
constexpr int PH0_I_IN = 16 * 224, PH0_I_UP = 8 * 32, PH0_I_OUT = 16 * 32, PH0_I_QB = 6 * 24, PH0_I_KVB = 4 * 32, PH0_I_GU = 16 * 176, PH0_I_DN = 44 * 32;
constexpr int PH0_NIT = PH0_I_IN + 3 * PH0_I_UP + PH0_I_OUT + PH0_I_QB + PH0_I_KVB + PH0_I_GU + PH0_I_DN, PH0_NIT_A = PH0_NIT - PH0_I_GU;
__device__ __forceinline__ void ph0_items(Frame& F, const Args& args, int l, int it0, int it1, int gw, int NGW) {
    LAS float* scr = (LAS float*)(F.lds + F.wave * 8704);
    unsigned char* ws = F.ws;
    constexpr int I_IN = PH0_I_IN, I_UP = PH0_I_UP, I_OUT = PH0_I_OUT, I_QB = PH0_I_QB, I_KVB = PH0_I_KVB, I_DN = PH0_I_DN;
    for (int it = it0 + gw; it < it1; it += NGW) {
        int r = it;
        if (r < I_IN) { transpose_item(FIN(I_WIN) + (size_t)l * DM * IN_COLS, IN_COLS, DM, (h16*)(ws + WS_WIN), FIN(I_ANORM) + l * DM, scr, r, 224, F.lane, MapIn()); continue; } r -= I_IN;
        if (r < 3 * I_UP) { const int br = r / I_UP; r -= br * I_UP; const float* W = (br == 0 ? FIN(I_WUPA) : (br == 1 ? FIN(I_WUPB) : FIN(I_WUPC))) + (size_t)l * 512 * DM;
            transpose_item(W, DM, 512, (h16*)(ws + WS_WUP) + (size_t)br * 512, nullptr, scr, r, 32, F.lane, MapId(), 1536); continue; } r -= 3 * I_UP;
        if (r < I_OUT) { transpose_item(FIN(I_WOUT) + (size_t)l * DM * DM, DM, DM, (h16*)(ws + WS_WOUT), nullptr, scr, r, 32, F.lane, MapId()); continue; } r -= I_OUT;
        if (r < I_QB) { transpose_item(FIN(I_WQB) + (size_t)l * 384 * 768, 768, 384, (h16*)(ws + WS_WQB), FIN(I_QNORM) + l * 384, scr, r, 24, F.lane, MapQb()); continue; } r -= I_QB;
        if (r < I_KVB) { transpose_item(FIN(I_WKVB) + (size_t)l * 256 * 1024, 1024, 256, (h16*)(ws + WS_WKVB), FIN(I_KVNORM) + l * 256, scr, r, 32, F.lane, MapId()); continue; } r -= I_KVB;
        if (r < I_DN) { transpose_item(FIN(I_WFD) + (size_t)l * DFF * DM, DM, DFF, (h16*)(ws + ((l & 1) ? WS_WDN2 : WS_WDN)), nullptr, scr, r, 32, F.lane, MapId()); continue; } r -= I_DN;
        { const int nb = r % 176; const bool up = ((nb * 32) & 255) >= 128;
            transpose_item((up ? FIN(I_WFU) : FIN(I_WFG)) + (size_t)l * DM * DFF, DFF, DM, (h16*)(ws + ((l & 1) ? WS_WGU2 : WS_WGU)), FIN(I_FNORM) + l * DM, scr, r, 176, F.lane, MapGU()); }
    }
}
__device__ __forceinline__ void ph0_convert(Frame& F, const Args& args, int l, int it0 = 0) {
    const int gw = F.bid * NWAVES + F.wave, NGW = F.G * NWAVES;
    unsigned char* ws = F.ws;
    ph0_items(F, args, l, it0, PH0_NIT, gw, NGW);
    const int gt = F.bid * NTHREADS + F.tid, NGT = F.G * NTHREADS;
    float* wiw = (float*)(ws + WS_SMALL + SM_WIW); float* lbv = (float*)(ws + WS_SMALL + SM_LB);
    for (int i = gt; i < DM * 8; i += NGT) { const int k = i >> 3, j = i & 7; wiw[i] = FIN(I_ANORM)[l * DM + k] * FIN(I_WIN)[(size_t)l * DM * IN_COLS + (size_t)k * IN_COLS + 1344 + j]; }
    for (int i = gt; i < 512; i += NGT) { const float* lg = FIN(I_LBLOG);
        const float v0 = lg[i], v1 = lg[512 + i], v2 = lg[1024 + i], v3 = lg[1536 + i]; const float mx = fmaxf(fmaxf(v0, v1), fmaxf(v2, v3));
        const float e0 = expf(v0 - mx), e1 = expf(v1 - mx), e2 = expf(v2 - mx), e3 = expf(v3 - mx), s = (e0 + e1) + (e2 + e3);
        float c = 0.f; if (l >= 1) c += e1 / s; if (l >= 2) c += e2 / s; if (l >= 3) c += e3 / s;
        lbv[i] = c; }
    if (l == 0) {
        const float* x = FIN(I_X); const int* pos = (const int*)FIN(I_POS);
        h16* x16 = (h16*)(ws + WS_X16); float* rsa = (float*)(ws + WS_RSA); float* cosT = (float*)(ws + WS_COS); float* sinT = (float*)(ws + WS_SIN);
        for (int m0 = gw; m0 < M; m0 += 4 * NGW) {
            f32x4 xv[4][4]; int pv[4];
#pragma unroll
            for (int u = 0; u < 4; ++u) { const int m = m0 + u * NGW < M ? m0 + u * NGW : m0; const f32x4* xr = (const f32x4*)(x + (size_t)m * DM) + F.lane;
#pragma unroll
                for (int j = 0; j < 4; ++j) xv[u][j] = xr[64 * j];
                pv[u] = pos[m]; }
#pragma unroll
            for (int u = 0; u < 4; ++u) { const int m = m0 + u * NGW; if (m >= M) break;
#pragma unroll
                for (int j = 0; j < 4; ++j) { const f32x4 v = xv[u][j]; float ss = (v[0] * v[0] + v[1] * v[1]) + (v[2] * v[2] + v[3] * v[3]);
                    u32x2 w; w.x = pkh(v[0], v[1]); w.y = pkh(v[2], v[3]); *((u32x2*)(x16 + (size_t)m * DM) + F.lane + 64 * j) = w;
                    ss += __shfl_xor(ss, 1); ss += __shfl_xor(ss, 2); ss += __shfl_xor(ss, 4); ss += __shfl_xor(ss, 8);
                    if ((F.lane & 15) == 0) rsa[(size_t)m * 16 + j * 4 + (F.lane >> 4)] = ss; }
                if (F.lane < 32) { const float inv_freq = exp2f(-(float)F.lane * (13.287712379549449f / 32.0f));
                    const float ang = (float)pv[u] * inv_freq; float sn, cs; sincosf(ang, &sn, &cs); cosT[(size_t)m * 32 + F.lane] = cs; sinT[(size_t)m * 32 + F.lane] = sn; } }
        }
        int* pmin32 = (int*)(ws + WS_SMALL + SM_PMIN); int* pmax64 = (int*)(ws + WS_SMALL + SM_PMAX);
        for (int g = gw; g < M / 64; g += NGW) { const int v = pos[g * 64 + F.lane];
            const int mx = wave_max_i(v), mn0 = -wave_max_i(F.lane < 32 ? -v : (int)0x80000000), mn1 = -wave_max_i(F.lane >= 32 ? -v : (int)0x80000000);
            if (F.lane == 0) { pmax64[g] = mx; pmin32[2 * g] = mn0; pmin32[2 * g + 1] = mn1; } }
    }
}

__device__ __forceinline__ float wave_sum_dpp(float v) {
    v += __builtin_bit_cast(float, __builtin_amdgcn_update_dpp(0, __builtin_bit_cast(int, v), 0xB1, 0xF, 0xF, true));
    v += __builtin_bit_cast(float, __builtin_amdgcn_update_dpp(0, __builtin_bit_cast(int, v), 0x4E, 0xF, 0xF, true));
    v += __builtin_bit_cast(float, __builtin_amdgcn_update_dpp(0, __builtin_bit_cast(int, v), 0x141, 0xF, 0xF, true));
    v += __builtin_bit_cast(float, __builtin_amdgcn_update_dpp(0, __builtin_bit_cast(int, v), 0x140, 0xF, 0xF, true));
    const int iv = __builtin_bit_cast(int, v);
    return (__builtin_bit_cast(float, __builtin_amdgcn_readlane(iv, 0)) + __builtin_bit_cast(float, __builtin_amdgcn_readlane(iv, 16))) + (__builtin_bit_cast(float, __builtin_amdgcn_readlane(iv, 32)) + __builtin_bit_cast(float, __builtin_amdgcn_readlane(iv, 48)));
}
__device__ __forceinline__ void ph2_rows(Frame& F) {
    unsigned char* ws = F.ws;
    LAS h16* whi_s = (LAS h16*)(F.lds); LAS h16* wlo_s = (LAS h16*)(F.lds + 8 * 1032 * 2);
    { const float* wiw = (const float*)(ws + WS_SMALL + SM_WIW);
      float wv[16];
#pragma unroll
      for (int q = 0; q < 16; ++q) wv[q] = wiw[F.tid + NTHREADS * q];
#pragma unroll
      for (int q = 0; q < 16; ++q) { const int i = F.tid + NTHREADS * q; const float w = wv[q]; const h16 hi = (h16)w; const h16 lo = (h16)((w - (float)hi) * 2048.0f); const int o = (i & 7) * 1032 + (i >> 3); whi_s[o] = hi; wlo_s[o] = lo; } }
    __syncthreads();
    const int gw = F.bid * NWAVES + F.wave, NGW = F.G * NWAVES;
    const h16* P = (const h16*)(ws + WS_P); const h16* x16 = (const h16*)(ws + WS_X16);
    const float* rsa = (const float*)(ws + WS_RSA); const float* cosT = (const float*)(ws + WS_COS); const float* sinT = (const float*)(ws + WS_SIN);
    float* rq = (float*)(ws + WS_SMALL + SM_RSTDQ); float* rkv = (float*)(ws + WS_SMALL + SM_RSTDKV); float* iw = (float*)(ws + WS_SMALL + SM_IW); h16* kpe = (h16*)(ws + WS_KPE);
    const int ri = F.lane & 7, kg = F.lane >> 4;
    for (int m0 = gw; m0 < M; m0 += 8 * NGW) {
        h16x8 xa[32];
        { const int mr = m0 + ri * NGW < M ? m0 + ri * NGW : m0; const h16* xr = x16 + (size_t)mr * DM + 8 * kg;
#pragma unroll
          for (int kb = 0; kb < 32; ++kb) xa[kb] = *(const h16x8*)(xr + 32 * kb); }
        h16x2 cqv[8][3], ckvv[8][2], kpv[8]; float rp[8]; float csv[8], snv[8];
#pragma unroll
        for (int u = 0; u < 8; ++u) { const int m = m0 + u * NGW < M ? m0 + u * NGW : m0; const h16* pr = P + (size_t)m * NP;
#pragma unroll
            for (int j = 0; j < 3; ++j) cqv[u][j] = *(const h16x2*)(pr + C_CQ + 2 * F.lane + 128 * j);
#pragma unroll
            for (int j = 0; j < 2; ++j) ckvv[u][j] = *(const h16x2*)(pr + C_CKV + 2 * F.lane + 128 * j);
            kpv[u] = *(const h16x2*)(pr + C_KPE + 2 * (F.lane & 31));
            rp[u] = rsa[(size_t)m * 16 + (F.lane & 15)];
            csv[u] = cosT[(size_t)m * 32 + (F.lane & 31)]; snv[u] = sinT[(size_t)m * 32 + (F.lane & 31)]; }
        __builtin_amdgcn_sched_barrier(0);
        f32x4 ah = {0.f, 0.f, 0.f, 0.f}, al = {0.f, 0.f, 0.f, 0.f};
        { const LAS h16* bh = whi_s + ri * 1032 + 8 * kg; const LAS h16* bl = wlo_s + ri * 1032 + 8 * kg;
#pragma unroll
          for (int kb = 0; kb < 32; ++kb) { const h16x8 b0 = *(const LAS h16x8*)(bh + 32 * kb), b1 = *(const LAS h16x8*)(bl + 32 * kb);
              ah = __builtin_amdgcn_mfma_f32_16x16x32_f16(xa[kb], b0, ah, 0, 0, 0); al = __builtin_amdgcn_mfma_f32_16x16x32_f16(xa[kb], b1, al, 0, 0, 0);
              if ((kb & 3) == 3) __builtin_amdgcn_sched_barrier(0); } }
        __builtin_amdgcn_sched_barrier(0);
        float rs8[8];
#pragma unroll
        for (int u = 0; u < 8; ++u) { const int m = m0 + u * NGW; rs8[u] = 0.f; if (m >= M) continue;
            float sq = 0.f, skv = 0.f;
#pragma unroll
            for (int j = 0; j < 3; ++j) { const float a = (float)cqv[u][j].x, b = (float)cqv[u][j].y; sq += a * a + b * b; }
#pragma unroll
            for (int j = 0; j < 2; ++j) { const float a = (float)ckvv[u][j].x, b = (float)ckvv[u][j].y; skv += a * a + b * b; }
            sq = wave_sum_dpp(sq); skv = wave_sum_dpp(skv);
            const float s = wave_sum_dpp(F.lane < 16 ? rp[u] : 0.f);
            rs8[u] = __builtin_amdgcn_rsqf(s * (1.0f / 1024.0f) + EPS);
            if (F.lane == 0) { rq[m] = __builtin_amdgcn_rsqf(sq * (1.0f / 384.0f) + EPS); rkv[m] = __builtin_amdgcn_rsqf(skv * (1.0f / 256.0f) + EPS); }
            if (F.lane < 32) { const float ka = (float)kpv[u].x, kb = (float)kpv[u].y;
                *(unsigned*)(kpe + (size_t)m * 64 + 2 * F.lane) = pkh(ka * csv[u] - kb * snv[u], kb * csv[u] + ka * snv[u]); }
        }
        if ((F.lane & 15) < 8 && kg < 2) {
#pragma unroll
            for (int r = 0; r < 4; ++r) { const int m = m0 + (4 * kg + r) * NGW; const float rsat = kg ? rs8[4 + r] : rs8[r];
                if (m < M) iw[(size_t)m * 8 + (F.lane & 15)] = (ah[r] + al[r] * (1.0f / 2048.0f)) * rsat; } }
    }
    __syncthreads();
}
__device__ __forceinline__ void hgrn_gate(float fr, float lb, float& lf, float& kin) {
    fr = fminf(fmaxf(fr, -30.f), 30.f); const float e = __builtin_amdgcn_exp2f(-1.4426950408889634f * fr), sg = __builtin_amdgcn_rcpf(1.0f + e);
    const float f = fmaxf(lb + (1.0f - lb) * sg, 1e-30f);
    lf = __logf(f);
    kin = (1.0f - lb) * (e * sg);
}
__device__ __forceinline__ void hgrn_gate_f(float fr, float lb, float& f, float& kin) {
    fr = fminf(fmaxf(fr, -30.f), 30.f); const float e = __builtin_amdgcn_exp2f(-1.4426950408889634f * fr), sg = __builtin_amdgcn_rcpf(1.0f + e);
    f = fmaxf(lb + (1.0f - lb) * sg, 1e-30f); kin = (1.0f - lb) * (e * sg);
}
__device__ __forceinline__ void hgrn_b1_unit(Frame& F, int b, int c) {
    unsigned char* ws = F.ws; const h16* HT = (const h16*)(ws + WS_HT);
    const float* lbv = (const float*)(ws + WS_SMALL + SM_LB); float* dc = (float*)(ws + WS_SMALL + SM_DC);
    unsigned short* ST = (unsigned short*)(ws + WS_ST);
    LAS unsigned char* khT = F.lds; LAS unsigned char* inT = F.lds + 65536;
    int col = F.tid; asm volatile("" : "+v"(col));
    const float lb = lbv[col];
    h16x8 fv[8];
    {
        const int ln = col & 63, rsub = ln >> 3, g = (ln & 7) ^ rsub;
#pragma unroll
        for (int j = 0; j < 8; ++j) { const int R = F.wave * 64 + 8 * j + rsub;
            const h16* src = HT + ((size_t)b * 512 + R) * SEQ + c * 64 + 8 * g;
            __builtin_amdgcn_global_load_lds((const unsigned*)(src + (size_t)HT_F * NB * 512 * SEQ), (LAS unsigned*)(khT + F.wave * 8192 + j * 1024), 16, 0, 0);
            __builtin_amdgcn_global_load_lds((const unsigned*)(src + (size_t)HT_I * NB * 512 * SEQ), (LAS unsigned*)(inT + F.wave * 8192 + j * 1024), 16, 0, 0); }
        asm volatile("s_waitcnt vmcnt(0)" ::: "memory");
#pragma unroll
        for (int ch = 0; ch < 8; ++ch) fv[ch] = *(const LAS h16x8*)(khT + col * 128 + ((ch ^ (col & 7)) * 16));
        LDS_WAIT();
    }
    float R = 1.0f;
#pragma unroll
    for (int ch = 7; ch >= 0; --ch) { float kv[8];
#pragma unroll
        for (int j = 7; j >= 0; --j) { float f, kin; hgrn_gate_f((float)fv[ch][j], lb, f, kin); kv[j] = kin * R; R *= f; }
        u32x4 wk; wk.x = pkh(kv[0], kv[1]); wk.y = pkh(kv[2], kv[3]); wk.z = pkh(kv[4], kv[5]); wk.w = pkh(kv[6], kv[7]);
        *(LAS u32x4*)(khT + col * 128 + ((ch ^ (col & 7)) * 16)) = wk; }
    dc[(size_t)(b * 32 + c) * 512 + col] = R;
    __syncthreads();
    const int h = F.wave >> 1, kh = F.wave & 1, r = col & 31, hh = (col >> 5) & 1;
    unsigned short* out = ST + ((size_t)((b * 4 + h) * 32 + c)) * 16384;
    for (int vt = 0; vt < 4; ++vt) {
        f32x16 acc0 = {}, acc1 = {};
        const int arow = h * 128 + vt * 32 + r, brow0 = h * 128 + (2 * kh) * 32 + r, brow1 = brow0 + 32;
#pragma unroll
        for (int sg = 0; sg < 4; ++sg) { const int ch = 2 * sg + hh;
            const h16x8 a = *(const LAS h16x8*)(inT + arow * 128 + ((ch ^ (arow & 7)) * 16));
            const h16x8 b0 = *(const LAS h16x8*)(khT + brow0 * 128 + ((ch ^ (brow0 & 7)) * 16));
            const h16x8 b1 = *(const LAS h16x8*)(khT + brow1 * 128 + ((ch ^ (brow1 & 7)) * 16));
            acc0 = __builtin_amdgcn_mfma_f32_32x32x16_f16(b0, a, acc0, 0, 0, 0);
            acc1 = __builtin_amdgcn_mfma_f32_32x32x16_f16(b1, a, acc1, 0, 0, 0); }
        __builtin_amdgcn_sched_barrier(0); asm volatile("s_nop 15\n\ts_nop 15"); __builtin_amdgcn_sched_barrier(0);
#pragma unroll
        for (int m2 = 0; m2 < 2; ++m2) {
            unsigned short* op = out + (size_t)(vt * 32 + r) * 128 + (2 * kh) * 32 + 16 * m2 + 8 * hh;
            unsigned a0x = pkb(acc0[8 * m2 + 0], acc0[8 * m2 + 1]), a0y = pkb(acc0[8 * m2 + 2], acc0[8 * m2 + 3]), b0x = pkb(acc0[8 * m2 + 4], acc0[8 * m2 + 5]), b0y = pkb(acc0[8 * m2 + 6], acc0[8 * m2 + 7]);
            unsigned a1x = pkb(acc1[8 * m2 + 0], acc1[8 * m2 + 1]), a1y = pkb(acc1[8 * m2 + 2], acc1[8 * m2 + 3]), b1x = pkb(acc1[8 * m2 + 4], acc1[8 * m2 + 5]), b1y = pkb(acc1[8 * m2 + 6], acc1[8 * m2 + 7]);
            asm volatile("s_nop 3" : "+v"(a0x), "+v"(a0y), "+v"(b0x), "+v"(b0y), "+v"(a1x), "+v"(a1y), "+v"(b1x), "+v"(b1y));
            const auto s0x = __builtin_amdgcn_permlane32_swap(a0x, b0x, false, false), s0y = __builtin_amdgcn_permlane32_swap(a0y, b0y, false, false);
            const auto s1x = __builtin_amdgcn_permlane32_swap(a1x, b1x, false, false), s1y = __builtin_amdgcn_permlane32_swap(a1y, b1y, false, false);
            u32x4 q0, q1; q0.x = s0x[0]; q0.y = s0y[0]; q0.z = s0x[1]; q0.w = s0y[1]; q1.x = s1x[0]; q1.y = s1y[0]; q1.z = s1x[1]; q1.w = s1y[1];
            *(u32x4*)op = q0; *(u32x4*)(op + 32) = q1; }
    }
    __syncthreads();
}
__device__ __forceinline__ void hgrn_scan_unit(Frame& F, int j, int dry = 0) {
    unsigned char* ws = F.ws; const float* dc = (const float*)(ws + WS_SMALL + SM_DC); unsigned short* ST = (unsigned short*)(ws + WS_ST);
    int tid_ = F.tid; asm volatile("" : "+v"(tid_));
    const int gid = j * NTHREADS + tid_, bh = gid >> 12, e = (gid & 4095) * 4, k = e & 127, b = bh >> 2, h = bh & 3;
    float s0 = 0.f, s1 = 0.f, s2 = 0.f, s3 = 0.f;
    u32x2 u[32];
#pragma unroll
    for (int i = 0; i < 32; ++i) u[i] = *(const u32x2*)(ST + ((size_t)(bh * 32 + i)) * 16384 + e);
#pragma unroll
    for (int c0 = 0; c0 < 32; c0 += 16) { f32x4 dv[16];
#pragma unroll
        for (int i = 0; i < 16; ++i) dv[i] = *(const f32x4*)(dc + (size_t)(b * 32 + c0 + i) * 512 + h * 128 + k);
#pragma unroll
        for (int i = 0; i < 16; ++i) { const int c = c0 + i; unsigned short* p = ST + ((size_t)(bh * 32 + c)) * 16384 + e;
            s0 = dv[i][0] * s0 + __uint_as_float(u[c].x << 16); s1 = dv[i][1] * s1 + __uint_as_float(u[c].x & 0xffff0000u);
            s2 = dv[i][2] * s2 + __uint_as_float(u[c].y << 16); s3 = dv[i][3] * s3 + __uint_as_float(u[c].y & 0xffff0000u);
            u32x2 w; w.x = pkb(s0, s1); w.y = pkb(s2, s3); *(u32x2*)(dry ? (unsigned short*)(ws + WS_X16) + ((size_t)(bh * 32 + c)) * 16384 + e : p) = w; }
    }
}
__device__ __forceinline__ int hgrn_b3_unit(Frame& F, const Args& args, int b, int c, int l, int hp_only, int dry, unsigned* qctr, volatile LAS unsigned* MISC, int pre, float lb_in) {
    unsigned char* ws = F.ws; h16* P = (h16*)(ws + WS_P); const h16* HT = (const h16*)(ws + WS_HT);
    const float* lbv = (const float*)(ws + WS_SMALL + SM_LB); const unsigned short* ST = (const unsigned short*)(ws + WS_ST);
    const float* gain = FIN(I_ONORM) + l * 128;
    LAS unsigned char* QT = F.lds;
    LAS unsigned char* KB = F.lds + 32768;
    LAS unsigned char* inT = F.lds + 65536;
    LAS float* red = (LAS float*)(F.lds + 98304);
    const size_t m0 = (size_t)b * SEQ + (size_t)c * 64;
    int tid_ = F.tid; asm volatile("" : "+v"(tid_));
    const int colp = tid_ & 255, half = tid_ >> 8, hlA = colp >> 7, kA = colp & 127, rowi = tid_ >> 1, c0i = (tid_ & 1) * 4, hli = rowi >> 7, vi = rowi & 127;
    auto issue_dma = [&](int b_, int c_, int hp_) {
        const int ln = tid_ & 63, rsub = ln >> 3, g = (ln & 7) ^ rsub;
#pragma unroll
        for (int j = 0; j < 4; ++j) { const int R = F.wave * 32 + 8 * j + rsub;
            const h16* src = HT + ((size_t)b_ * 512 + (size_t)(2 * hp_ + (R >> 7)) * 128 + (R & 127)) * SEQ + c_ * 64 + 8 * g;
            __builtin_amdgcn_global_load_lds((const unsigned*)(src + (size_t)HT_F * NB * 512 * SEQ), (LAS unsigned*)(KB + F.wave * 4096 + j * 1024), 16, 0, 0);
            __builtin_amdgcn_global_load_lds((const unsigned*)(src + (size_t)HT_Q * NB * 512 * SEQ), (LAS unsigned*)(QT + F.wave * 4096 + j * 1024), 16, 0, 0);
            __builtin_amdgcn_global_load_lds((const unsigned*)(src + (size_t)HT_I * NB * 512 * SEQ), (LAS unsigned*)(inT + F.wave * 4096 + j * 1024), 16, 0, 0); }
    };
    int pre_out = 0;
    auto do_pass = [&](int hp) {
        const int hl = F.wave >> 2, ti = (F.wave >> 1) & 1, vh = F.wave & 1, h = 2 * hp + hl, r = tid_ & 31, hh = (tid_ >> 5) & 1;
        h16x8 fv[4], qv8[4]; float lb; bf16x8 sa0[8], sa1[8];
        {
            lb = lb_in;
            if (!pre) issue_dma(b, c, hp);
            asm volatile("s_waitcnt vmcnt(0)" ::: "memory");
            __syncthreads();
            if (c > 0) { const unsigned short* Sp = ST + ((size_t)((b * 4 + h) * 32 + (c - 1))) * 16384;
#pragma unroll
                for (int ks = 0; ks < 8; ++ks) { sa0[ks] = *(const bf16x8*)(Sp + (size_t)((2 * vh) * 32 + r) * 128 + 16 * ks + 8 * hh); sa1[ks] = *(const bf16x8*)(Sp + (size_t)((2 * vh + 1) * 32 + r) * 128 + 16 * ks + 8 * hh); } }
#pragma unroll
            for (int ch = 0; ch < 4; ++ch) { const int pos = ((4 * half + ch) ^ (colp & 7)) * 16;
                fv[ch] = *(const LAS h16x8*)(KB + colp * 128 + pos); qv8[ch] = *(const LAS h16x8*)(QT + colp * 128 + pos); }
            LDS_WAIT();
            __syncthreads();
        }
        {
            float fa[32], kna[32]; float Lp = 1.0f;
#pragma unroll
            for (int ch = 0; ch < 4; ++ch)
#pragma unroll
                for (int j = 0; j < 8; ++j) { hgrn_gate_f((float)fv[ch][j], lb, fa[ch * 8 + j], kna[ch * 8 + j]); Lp *= fa[ch * 8 + j]; }
            if (half == 0) red[256 + colp] = Lp;
            __syncthreads();
            float Pr = half ? red[256 + colp] : 1.0f;
#pragma unroll
            for (int i = 0; i < 32; ++i) { const int s = 32 * half + i; Pr *= fa[i];
                const float Pc = fmaxf(Pr, 1.2e-37f); const float qv = (float)qv8[i >> 3][i & 7] * 0.08838834764831845f * Pc, kvv = kna[i] * __builtin_amdgcn_rcpf(Pc);
                const int off = hlA * 16384 + s * 256 + (((kA >> 3) ^ (s & 15)) * 16) + (kA & 7) * 2;
                *(LAS unsigned short*)(QT + off) = (unsigned short)(pkb(qv, 0.f) & 0xffffu); *(LAS unsigned short*)(KB + off) = (unsigned short)(pkb(kvv, 0.f) & 0xffffu); }
        }
        __syncthreads();
        f32x16 o0 = {}, o1 = {};
        const int trow = ti * 32 + r;
        const LAS unsigned char* qrow = QT + hl * 16384 + trow * 256;
        const size_t m = m0 + trow; h16* orow = dry ? ((h16*)(ws + WS_X16) + m * 512 + h * 128) : (P + m * NP + C_OB + h * 128); const h16* grow = P + m * NP + C_BG + h * 128;
        u32x4 gq[2][2]; f32x4 gnv[2][4];
#pragma unroll
        for (int vt = 0; vt < 2; ++vt) {
#pragma unroll
            for (int m2 = 0; m2 < 2; ++m2) gq[vt][m2] = *(const u32x4*)(grow + (2 * vh + vt) * 32 + 16 * m2 + 8 * hh);
#pragma unroll
            for (int g4 = 0; g4 < 4; ++g4) gnv[vt][g4] = *(const f32x4*)(gain + (2 * vh + vt) * 32 + 8 * g4 + 4 * hh); }
        unsigned nx = 0u; if (tid_ == 0) nx = __hip_atomic_fetch_add(qctr, 1u, __ATOMIC_RELAXED, __HIP_MEMORY_SCOPE_AGENT);
        if (c > 0) {
#pragma unroll
            for (int ks = 0; ks < 8; ++ks) { const bf16x8 qb = *(const LAS bf16x8*)(qrow + (((2 * ks + hh) ^ (trow & 15)) * 16));
                o0 = __builtin_amdgcn_mfma_f32_32x32x16_bf16(sa0[ks], qb, o0, 0, 0, 0);
                o1 = __builtin_amdgcn_mfma_f32_32x32x16_bf16(sa1[ks], qb, o1, 0, 0, 0); }
        }
        for (int sj = 0; sj <= ti; ++sj) {
            f32x16 at = {};
            const int srow = sj * 32 + r; const LAS unsigned char* krow = KB + hl * 16384 + srow * 256;
#pragma unroll
            for (int ks = 0; ks < 8; ++ks) { const bf16x8 qb = *(const LAS bf16x8*)(qrow + (((2 * ks + hh) ^ (trow & 15)) * 16));
                const bf16x8 ka = *(const LAS bf16x8*)(krow + (((2 * ks + hh) ^ (srow & 15)) * 16));
                at = __builtin_amdgcn_mfma_f32_32x32x16_bf16(ka, qb, at, 0, 0, 0); }
            if (sj == ti) {
#pragma unroll
                for (int q = 0; q < 16; ++q) if (crow(q, hh) > r) at[q] = 0.f; }
#pragma unroll
            for (int sg = 0; sg < 2; ++sg) {
                u32x4 pw; pw.x = pkh(at[8 * sg + 0], at[8 * sg + 1]); pw.y = pkh(at[8 * sg + 2], at[8 * sg + 3]); pw.z = pkh(at[8 * sg + 4], at[8 * sg + 5]); pw.w = pkh(at[8 * sg + 6], at[8 * sg + 7]);
                const h16x8 pb = __builtin_bit_cast(h16x8, pw);
                const int ch = 4 * sj + 2 * sg;
#pragma unroll
                for (int vt = 0; vt < 2; ++vt) { const int vrow = (2 * vh + vt) * 32 + r; const LAS unsigned char* ir = inT + (hl * 128 + vrow) * 128 + 8 * hh;
                    const u32x2 lo = *(const LAS u32x2*)(ir + ((ch ^ (vrow & 7)) * 16)), hi2 = *(const LAS u32x2*)(ir + (((ch + 1) ^ (vrow & 7)) * 16));
                    u32x4 aw; aw.x = lo.x; aw.y = lo.y; aw.z = hi2.x; aw.w = hi2.y;
                    if (vt == 0) o0 = __builtin_amdgcn_mfma_f32_32x32x16_f16(__builtin_bit_cast(h16x8, aw), pb, o0, 0, 0, 0);
                    else o1 = __builtin_amdgcn_mfma_f32_32x32x16_f16(__builtin_bit_cast(h16x8, aw), pb, o1, 0, 0, 0); }
            }
        }
        float ss = 0.f;
#pragma unroll
        for (int q = 0; q < 16; ++q) ss += o0[q] * o0[q] + o1[q] * o1[q];
        ss += __shfl_xor(ss, 32);
        if (hh == 0) red[F.wave * 32 + r] = ss;
        if (tid_ == 0) MISC[16] = (nx < 1024u) ? (((nx & 7u) << 7) | (nx >> 3)) : 0xffffffffu;
        __syncthreads();
        const float tot = red[F.wave * 32 + r] + red[(F.wave ^ 1) * 32 + r];
        { const unsigned nc = MISC[16];
          LDS_WAIT(); asm volatile("" :: "v"(gnv[1][3]), "v"(gq[1][1]));
          if (nc != 0xffffffffu && (nc & 127u) >= 64u) { issue_dma((int)(nc >> 7), (int)(((nc & 127u) - 64u) >> 1), (int)((nc & 127u) - 64u) & 1); pre_out = 1; } }
        const float rs = __builtin_amdgcn_rsqf(tot * (1.0f / 128.0f) + EPS);
#pragma unroll
        for (int vt = 0; vt < 2; ++vt)
#pragma unroll
            for (int m2 = 0; m2 < 2; ++m2) {
                const u32x4 gqv = gq[vt][m2];
                const auto gx = __builtin_amdgcn_permlane32_swap(gqv.x, gqv.z, false, false), gy = __builtin_amdgcn_permlane32_swap(gqv.y, gqv.w, false, false);
                unsigned wv[2][2];
#pragma unroll
                for (int gg = 0; gg < 2; ++gg) { const int g4 = 2 * m2 + gg;
                    u32x2 gw2; gw2.x = gx[gg]; gw2.y = gy[gg]; const h16x4 gv = __builtin_bit_cast(h16x4, gw2); const f32x4 gn = gnv[vt][g4]; float y[4];
#pragma unroll
                    for (int j = 0; j < 4; ++j) { const float ov = (vt == 0 ? o0[4 * g4 + j] : o1[4 * g4 + j]); const float g = (float)gv[j]; y[j] = ov * rs * gn[j] * (g * sigmoidf_(g)); }
                    wv[gg][0] = pkh(y[0], y[1]); wv[gg][1] = pkh(y[2], y[3]); }
                const auto sx = __builtin_amdgcn_permlane32_swap(wv[0][0], wv[1][0], false, false), sy = __builtin_amdgcn_permlane32_swap(wv[0][1], wv[1][1], false, false);
                u32x4 q; q.x = sx[0]; q.y = sy[0]; q.z = sx[1]; q.w = sy[1];
                *(u32x4*)(orow + (2 * vh + vt) * 32 + 16 * m2 + 8 * hh) = q; }
        __syncthreads();
    };
    do_pass(hp_only);
    return pre_out;
}
__device__ __forceinline__ unsigned fkey(float v) { unsigned u = __float_as_uint(v); u = (u & 0x80000000u) ? ~u : (u | 0x80000000u); return (v == 0.0f) ? 0x80000000u : u; }
__device__ __forceinline__ int wave_sum_i(int v) {
    v += __builtin_amdgcn_update_dpp(0, v, 0xB1, 0xF, 0xF, true);
    v += __builtin_amdgcn_update_dpp(0, v, 0x4E, 0xF, 0xF, true);
    v += __builtin_amdgcn_update_dpp(0, v, 0x141, 0xF, 0xF, true);
    v += __builtin_amdgcn_update_dpp(0, v, 0x140, 0xF, 0xF, true);
    return __builtin_amdgcn_readlane(v, 0) + __builtin_amdgcn_readlane(v, 16) + __builtin_amdgcn_readlane(v, 32) + __builtin_amdgcn_readlane(v, 48);
}
__device__ __forceinline__ float half_sum(float v) { const auto r = __builtin_amdgcn_permlane32_swap(__float_as_uint(v), __float_as_uint(v), false, false); return __uint_as_float(r[0]) + __uint_as_float(r[1]); }
__device__ __forceinline__ float half_max(float v) { const auto r = __builtin_amdgcn_permlane32_swap(__float_as_uint(v), __float_as_uint(v), false, false); return fmaxf(__uint_as_float(r[0]), __uint_as_float(r[1])); }
__device__ __forceinline__ void bit_transpose32(unsigned (&a)[32]) {
#pragma unroll
    for (int k = 0; k < 16; ++k) { const unsigned lo = a[k], hi = a[k + 16]; a[k] = __builtin_amdgcn_perm(hi, lo, 0x05040100u); a[k + 16] = __builtin_amdgcn_perm(hi, lo, 0x07060302u); }
#pragma unroll
    for (int k = 0; k < 32; ++k) if (!(k & 8)) { const unsigned lo = a[k], hi = a[k + 8]; a[k] = __builtin_amdgcn_perm(hi, lo, 0x06020400u); a[k + 8] = __builtin_amdgcn_perm(hi, lo, 0x07030501u); }
#pragma unroll
    for (int k = 0; k < 32; ++k) if (!(k & 4)) { const unsigned lo = a[k], hi = a[k + 4]; const unsigned m = 0x0f0f0f0fu; a[k] = (lo & m) | ((hi << 4) & ~m); a[k + 4] = ((lo >> 4) & m) | (hi & ~m); }
#pragma unroll
    for (int k = 0; k < 32; ++k) if (!(k & 2)) { const unsigned lo = a[k], hi = a[k + 2]; const unsigned m = 0x33333333u; a[k] = (lo & m) | ((hi << 2) & ~m); a[k + 2] = ((lo >> 2) & m) | (hi & ~m); }
#pragma unroll
    for (int k = 0; k < 32; ++k) if (!(k & 1)) { const unsigned lo = a[k], hi = a[k + 1]; const unsigned m = 0x55555555u; a[k] = (lo & m) | ((hi << 1) & ~m); a[k + 1] = ((lo >> 1) & m) | (hi & ~m); }
}
__device__ __forceinline__ void select_emit(unsigned gt, unsigned eq, int need, bool all_eq, int lane, unsigned long long* mrow) {
    unsigned wlo = 0u, whi = 0u;
    if (all_eq) {
        const unsigned sel = gt | eq;
#pragma unroll
        for (int j = 0; j < 32; ++j) { const unsigned long long w = __ballot(((sel >> j) & 1u) != 0u);
            const unsigned w0 = (unsigned)w, w1 = (unsigned)(w >> 32);
            asm("s_nop 4\n\tv_writelane_b32 %0, %2, %4\n\tv_writelane_b32 %1, %3, %4" : "+v"(wlo), "+v"(whi) : "s"(w0), "s"(w1), "n"(j)); }
    } else {
#pragma unroll 1
        for (int j = 0; j < 32; ++j) {
            const unsigned long long gw = __ballot(((gt >> j) & 1u) != 0u), ew = __ballot(((eq >> j) & 1u) != 0u); unsigned long long take;
            const int pc = __builtin_popcountll(ew);
            if (pc <= need) { take = ew; need -= pc; }
            else { unsigned long long mrem = ew; take = 0ull; for (int i = 0; i < need; ++i) { const unsigned long long low = mrem & (0ull - mrem); take |= low; mrem ^= low; } need = 0; }
            const unsigned long long w = gw | take;
            wlo = (lane == j) ? (unsigned)w : wlo; whi = (lane == j) ? (unsigned)(w >> 32) : whi; }
    }
    if (lane < 32) mrow[lane] = ((unsigned long long)whi << 32) | wlo;
}
__device__ __forceinline__ void select_rows2b(const LAS float* srowA, int tA, unsigned long long* mrowA, int lane, int nj) {
    unsigned pa[32], pb[32];
#pragma unroll
    for (int blk = 0; blk < 8; ++blk) {
        if (4 * blk < nj) {
#pragma unroll
            for (int jj = 0; jj < 4; ++jj) { const int j = 4 * blk + jj, s = j * 64 + lane; pa[j] = (s <= tA) ? __float_as_uint(srowA[s]) : 0u; pb[j] = (s <= tA + 1) ? __float_as_uint(srowA[2048 + s]) : 0u; }
        } else {
#pragma unroll
            for (int jj = 0; jj < 4; ++jj) { pa[4 * blk + jj] = 0u; pb[4 * blk + jj] = 0u; } } }
    bit_transpose32(pa); bit_transpose32(pb);
    unsigned gtA = 0u, eqA = 0xffffffffu, gtB = 0u, eqB = 0xffffffffu; bool dA = false, dB = false;
#pragma unroll
    for (int bit = 31; bit >= 0; --bit) {
        const unsigned xa = eqA & pa[bit], xb = eqB & pb[bit]; const unsigned ca = gtA | xa, cb = gtB | xb;
        const int pk = wave_sum_i(__builtin_popcount(ca) | (__builtin_popcount(cb) << 16)); const int na = pk & 0xffff, nb = pk >> 16;
        if (!dA) { if (na >= 256) { if (na == 256) { dA = true; gtA = ca; eqA = 0u; } else eqA = xa; } else { gtA = ca; eqA ^= xa; } }
        if (!dB) { if (nb >= 256) { if (nb == 256) { dB = true; gtB = cb; eqB = 0u; } else eqB = xb; } else { gtB = cb; eqB ^= xb; } }
        if (dA && dB) break; }
    const int pg = wave_sum_i(__builtin_popcount(gtA) | (__builtin_popcount(gtB) << 16)), pe = wave_sum_i(__builtin_popcount(eqA) | (__builtin_popcount(eqB) << 16));
    const int needA = 256 - (pg & 0xffff), needB = 256 - (pg >> 16);
    select_emit(gtA, eqA, needA, (pe & 0xffff) <= needA, lane, mrowA);
    select_emit(gtB, eqB, needB, (pe >> 16) <= needB, lane, mrowA + 32);
}
__device__ __forceinline__ void score_select_unit(Frame& F, int b, int g) {
    unsigned char* ws = F.ws; const h16* P = (const h16*)(ws + WS_P); const h16* IKC = (const h16*)(ws + WS_IKC);
    unsigned long long* mask = (unsigned long long*)(ws + WS_MASK);
    const int t0 = 16 * g; const size_t mb = (size_t)b * SEQ;
    int lane_ = F.lane; asm volatile("" : "+v"(lane_));
    if (g < 16) {
        for (int q = 2 * F.wave; q < 2 * F.wave + 2; ++q) { const int t = t0 + q;
            if (F.lane < 32) { const int lo = 64 * F.lane; unsigned long long w;
                if (t >= lo + 63) w = ~0ull; else if (t < lo) w = 0ull; else w = (1ull << (t - lo + 1)) - 1ull;
                mask[(mb + t) * 32 + F.lane] = w; } }
        return;
    }
    LAS float* sc = (LAS float*)F.lds;
    LAS float* iw_s = (LAS float*)(F.lds + 131072);
    const float* iw = (const float*)(ws + WS_SMALL + SM_IW);
    if (F.tid < 128) iw_s[F.tid] = iw[(mb + t0) * 8 + F.tid];
    const int r = lane_ & 31, hh = lane_ >> 5;
    const int aqq = 2 * ((r >> 2) & 1) + (r >> 4), aqh = 4 * ((r >> 3) & 1) + (r & 3);
    h16x8 aq[4][4];
#pragma unroll
    for (int rt = 0; rt < 4; ++rt)
#pragma unroll
        for (int ks = 0; ks < 4; ++ks) aq[rt][ks] = *(const h16x8*)(P + (mb + t0 + 4 * rt + aqq) * NP + C_IQ + aqh * 64 + 16 * ks + 8 * hh);
    __syncthreads();
    const int nkb = (t0 + 16 + 31) >> 5;
#ifndef REP_MASK
#define REP_MASK 0
#endif
    for (int rep_ = 0; rep_ < (((REP_MASK >> 13) & 1) ? 2 : 1); ++rep_) {
    h16x8 bk[4], bn[4], bm[4];
    if (F.wave < nkb) { const int k1 = (F.wave + 8 < nkb) ? F.wave + 8 : F.wave;
#pragma unroll
        for (int ks = 0; ks < 4; ++ks) { bk[ks] = *(const h16x8*)(IKC + (mb + F.wave * 32 + r) * 64 + 16 * ks + 8 * hh); bn[ks] = *(const h16x8*)(IKC + (mb + k1 * 32 + r) * 64 + 16 * ks + 8 * hh); } }
    for (int kb = F.wave; kb < nkb; kb += 8) {
        const int kn = (kb + 16 < nkb) ? kb + 16 : kb;
#pragma unroll
        for (int ks = 0; ks < 4; ++ks) bm[ks] = *(const h16x8*)(IKC + (mb + kn * 32 + r) * 64 + 16 * ks + 8 * hh);
#pragma unroll
        for (int rt = 0; rt < 4; ++rt) {
            f32x16 acc = {};
#pragma unroll
            for (int ks = 0; ks < 4; ++ks) acc = __builtin_amdgcn_mfma_f32_32x32x16_f16(aq[rt][ks], bk[ks], acc, 0, 0, 0);
#pragma unroll
            for (int z = 0; z < 2; ++z) { const int ql = 4 * rt + 2 * hh + z; const f32x4 w0 = *(const LAS f32x4*)(iw_s + ql * 8), w1 = *(const LAS f32x4*)(iw_s + ql * 8 + 4);
                const float plo = w0[0] * fmaxf(acc[8 * z + 0], 0.f) + w0[1] * fmaxf(acc[8 * z + 1], 0.f) + w0[2] * fmaxf(acc[8 * z + 2], 0.f) + w0[3] * fmaxf(acc[8 * z + 3], 0.f);
                const float phi = w1[0] * fmaxf(acc[8 * z + 4], 0.f) + w1[1] * fmaxf(acc[8 * z + 5], 0.f) + w1[2] * fmaxf(acc[8 * z + 6], 0.f) + w1[3] * fmaxf(acc[8 * z + 7], 0.f);
                sc[ql * 2048 + kb * 32 + r] = __uint_as_float(fkey(plo + phi)); }
        }
#pragma unroll
        for (int ks = 0; ks < 4; ++ks) { bk[ks] = bn[ks]; bn[ks] = bm[ks]; }
    }
    }
    __syncthreads();
    for (int rep_ = 0; rep_ < (((REP_MASK >> 14) & 1) ? 2 : 1); ++rep_) {
        const int q = 2 * F.wave, t = t0 + q; const int nj = ((t + 1) >> 6) + 1;
        unsigned long long* mrow = mask + (mb + t) * 32;
        select_rows2b(sc + q * 2048, t, mrow, lane_, nj);
    }
    __syncthreads();
}

template <int MODE>
__device__ __forceinline__ void attn_unit(Frame& F, const Args& args, int b, int hsel, int qb, int dry, unsigned* qctr, volatile LAS unsigned* MISC) {
    constexpr int DQK = MODE == 0 ? 192 : 128, NKS = DQK / 16, KROW = DQK * 2 + 16, KTILE = 64 * KROW, VROW = 144, VTILE = 128 * VROW, NKC = DQK / 8;
    unsigned char* ws = F.ws; h16* P = (h16*)(ws + WS_P);
    const h16* QC = (const h16*)(ws + WS_QC); const h16* KN = (const h16*)(ws + WS_KN); const h16* KPE = (const h16*)(ws + WS_KPE);
    const h16* VT = MODE == 0 ? ((const h16*)(ws + WS_VCT) + (size_t)(b * 4 + hsel) * 128 * SEQ) : ((const h16*)(ws + WS_AVT) + (size_t)b * 128 * SEQ);
    const unsigned* mask = (const unsigned*)(ws + WS_MASK); const int* pos = (const int*)FIN(I_POS);
    LAS unsigned char* Kl = F.lds;
    LAS unsigned char* Vl = F.lds + 2 * KTILE;
    LAS float* tabB = (LAS float*)(F.lds + 2 * KTILE + 2 * VTILE);
    LAS int* posk = (LAS int*)(F.lds + 2 * KTILE + 2 * VTILE + 2048);
    LAS unsigned* maskL = (LAS unsigned*)(F.lds + 2 * KTILE + 2 * VTILE + 2048 + 512);
    const size_t mb = (size_t)b * SEQ;
    int lane_ = F.lane; asm volatile("" : "+v"(lane_));
    int tid_ = F.tid; asm volatile("" : "+v"(tid_));
    const int r = lane_ & 31, hh = lane_ >> 5;
    const int head = MODE == 0 ? hsel : (F.wave >> 1);
    const int tq = MODE == 0 ? (qb * 256 + F.wave * 32 + r) : (qb * 64 + (F.wave & 1) * 32 + r);
    const int tq_hi = MODE == 0 ? (qb * 256 + F.wave * 32 + 31) : (qb * 64 + (F.wave & 1) * 32 + 31);
    const int nt = MODE == 0 ? (4 * qb + 4) : ((((REP_MASK >> 19) & 1) && dry) ? ((qb + 2) >> 1) : (qb + 1));
    constexpr float SCL = MODE == 0 ? 0.07216878364870322f : 0.08838834764831845f;
    constexpr float L2E = 1.4426950408889634f;
    if (MODE == 1) {
        if (tid_ < 128) { const int d = tid_; int bk;
            if (d < 16) bk = d; else bk = 16 + (d >= 19) + (d >= 21) + (d >= 24) + (d >= 27) + (d >= 31) + (d >= 35) + (d >= 40) + (d >= 46) + (d >= 52) + (d >= 59) + (d >= 67) + (d >= 77) + (d >= 87) + (d >= 99) + (d >= 113);
            const float* rb = FIN(I_RELB) + bk * 4; tabB[d * 4 + 0] = rb[0] * L2E; tabB[d * 4 + 1] = rb[1] * L2E; tabB[d * 4 + 2] = rb[2] * L2E; tabB[d * 4 + 3] = rb[3] * L2E; }
    }
    if (MODE == 1) {
#pragma unroll
        for (int i = 0; i < 2; ++i) { const int ci = tid_ + 512 * i, rowq = ci >> 4, cc = ci & 15;
            const u32x4 v = *(const u32x4*)(mask + (mb + qb * 64 + rowq) * 64 + 4 * cc);
            LAS unsigned* d = maskL + rowq * 66 + 4 * cc; d[0] = v.x; d[1] = v.y; d[2] = v.z; d[3] = v.w; }
    }
    h16x8 qf[NKS];
    { const h16* qp = MODE == 0 ? (QC + (mb + tq) * 768 + head * 192) : (P + (mb + tq) * NP + C_AQ + head * 128);
#pragma unroll
        for (int ks = 0; ks < NKS; ++ks) qf[ks] = *(const h16x8*)(qp + 16 * ks + 8 * hh) * (h16)(SCL * L2E); }
    const int posq = MODE == 1 ? pos[mb + tq] : 0;
    unsigned farbits = 0u;
    if (MODE == 1) { const int* pmin32 = (const int*)(ws + WS_SMALL + SM_PMIN); const int* pmax64 = (const int*)(ws + WS_SMALL + SM_PMAX);
        const int pqmin = pmin32[b * 64 + qb * 2 + (F.wave & 1)]; const int km = pmax64[b * 32 + r];
        farbits = (unsigned)__ballot(pqmin - km >= 127); }
    const int skey = tid_ >> 3, sc8 = tid_ & 7;
    u32x4 stK[NKC / 8], stV[2]; int stPos = 0;
    const int vd_ = tid_ >> 2, vg_ = tid_ & 3;
    auto load_tile = [&](int kt) {
        const size_t km = mb + (size_t)kt * 64 + skey;
        if (MODE == 0) { const h16* kn = KN + km * 512 + head * 128;
            stK[0] = *(const u32x4*)(kn + 8 * sc8); stK[1] = *(const u32x4*)(kn + 64 + 8 * sc8); stK[2] = *(const u32x4*)(KPE + km * 64 + 8 * sc8); }
        else { const h16* kp = P + km * NP + C_AK;
            stK[0] = *(const u32x4*)(kp + 8 * sc8); stK[1] = *(const u32x4*)(kp + 64 + 8 * sc8);
            if (sc8 == 0) stPos = pos[km]; }
        const h16* vp = VT + (size_t)vd_ * SEQ + kt * 64 + 16 * vg_;
        stV[0] = *(const u32x4*)vp; stV[1] = *(const u32x4*)(vp + 8);
    };
    auto store_tile = [&](int buf) {
        LAS unsigned char* kd = Kl + buf * KTILE + skey * KROW + sc8 * 16;
#pragma unroll
        for (int i = 0; i < NKC / 8; ++i) *(LAS u32x4*)(kd + 128 * i) = stK[i];
        LAS unsigned char* vd = Vl + buf * VTILE + vd_ * VROW + vg_ * 32;
        u32x4 c0, c1; c0.x = stV[0].x; c0.y = stV[0].y; c0.z = stV[1].x; c0.w = stV[1].y; c1.x = stV[0].z; c1.y = stV[0].w; c1.z = stV[1].z; c1.w = stV[1].w;
        *(LAS u32x4*)vd = c0; *(LAS u32x4*)(vd + 16) = c1;
        if (MODE == 1 && sc8 == 0) posk[buf * 64 + skey] = stPos;
    };
    float m_run = -1e30f, l_run = 0.f;
    f32x16 o[4]; o[0] = f32x16{}; o[1] = f32x16{}; o[2] = f32x16{}; o[3] = f32x16{};
    load_tile(0); store_tile(0);
    __syncthreads();
    const int nt_w = MODE == 1 ? nt : (tq_hi >> 6) + 1;
    float bcfar = 0.f;
    if (MODE == 1) bcfar = __builtin_bit_cast(float, __builtin_amdgcn_readfirstlane(__builtin_bit_cast(int, tabB[127 * 4 + head])));
    auto tile = [&](int kt) {
        const int buf = kt & 1;
        if (MODE == 1) asm volatile("; ATTN1_TILE_BEGIN"); else asm volatile("; ATTN0_TILE_BEGIN");
        if (kt + 1 < nt) load_tile(kt + 1);
        {
            f32x16 s0 = {}, s1 = {};
            const LAS unsigned char* kb_ = Kl + buf * KTILE + r * KROW + hh * 16;
            constexpr int NG = NKS / 2;
            h16x8 kf[2][4];
#define LDKG(g, dst) do { _Pragma("unroll") for (int i_ = 0; i_ < 2; ++i_) { const int ks_ = 2 * (g) + i_; \
                dst[2 * i_] = *(const LAS h16x8*)(kb_ + ks_ * 32); dst[2 * i_ + 1] = *(const LAS h16x8*)(kb_ + ks_ * 32 + 32 * KROW); } } while (0)
            LDKG(0, kf[0]);
#pragma unroll
            for (int g = 0; g < NG; ++g) {
                if (g + 1 < NG) LDKG(g + 1, kf[(g + 1) & 1]);
#pragma unroll
                for (int i = 0; i < 2; ++i) { s0 = __builtin_amdgcn_mfma_f32_32x32x16_f16(kf[g & 1][2 * i], qf[2 * g + i], s0, 0, 0, 0);
                    s1 = __builtin_amdgcn_mfma_f32_32x32x16_f16(kf[g & 1][2 * i + 1], qf[2 * g + i], s1, 0, 0, 0); }
                __builtin_amdgcn_sched_barrier(0);
            }
#undef LDKG
            float bc = 0.f; unsigned mw0 = 0u, mw1 = 0u;
            if (MODE == 1) {
                const LAS unsigned* mrow_ = maskL + ((F.wave & 1) * 32 + r) * 66 + 2 * kt;
                mw0 = mrow_[0] >> (4 * hh); mw1 = mrow_[1] >> (4 * hh);
                if ((farbits >> kt) & 1u) bc = bcfar;
                else {
#pragma unroll
                    for (int q = 0; q < 16; ++q) { const int kl = (q & 3) + 8 * (q >> 2) + 4 * hh;
                        int d0 = posq - posk[buf * 64 + kl]; d0 = d0 < 0 ? 0 : (d0 > 127 ? 127 : d0);
                        int d1 = posq - posk[buf * 64 + 32 + kl]; d1 = d1 < 0 ? 0 : (d1 > 127 ? 127 : d1);
                        float a0 = s0[q], a1 = s1[q];
                        asm("v_add_f32 %0, %0, %1" : "+v"(a0) : "v"(tabB[d0 * 4 + head]));
                        asm("v_add_f32 %0, %0, %1" : "+v"(a1) : "v"(tabB[d1 * 4 + head]));
                        s0[q] = a0; s1[q] = a1; }
                }
            }
            float pmax = s0[0];
#pragma unroll
            for (int q = 1; q < 16; ++q) pmax = fmaxf(pmax, s0[q]);
#pragma unroll
            for (int q = 0; q < 16; ++q) pmax = fmaxf(pmax, s1[q]);
            pmax = half_max(pmax) + bc;
            const float m_new = fmaxf(m_run, pmax);
            const float alpha = __builtin_amdgcn_exp2f(m_run - m_new);
            m_run = m_new;
            const float mm = m_new - bc - 8.0f;
            const f32x2_t mm2 = {mm, mm};
#pragma unroll
            for (int q = 0; q < 16; q += 2) { f32x2_t t0 = {s0[q], s0[q + 1]}, t1 = {s1[q], s1[q + 1]}; t0 -= mm2; t1 -= mm2;
                s0[q] = __builtin_amdgcn_exp2f(t0.x); s0[q + 1] = __builtin_amdgcn_exp2f(t0.y); s1[q] = __builtin_amdgcn_exp2f(t1.x); s1[q + 1] = __builtin_amdgcn_exp2f(t1.y); }
            if (MODE == 1) {
#pragma unroll
                for (int q = 0; q < 16; ++q) { const int c = (q & 3) + 8 * (q >> 2);
                    int b0, b1; asm("v_bfe_i32 %0, %1, %2, 1" : "=v"(b0) : "v"(mw0), "n"(c)); asm("v_bfe_i32 %0, %1, %2, 1" : "=v"(b1) : "v"(mw1), "n"(c));
                    const float e0 = s0[q], e1 = s1[q];
                    s0[q] = __int_as_float(__float_as_int(e0) & b0); s1[q] = __int_as_float(__float_as_int(e1) & b1); }
            } else if (kt == nt_w - 1) {
                const int nv0 = tq - 64 * kt + 1, nv1 = nv0 - 32;
                mw0 = (nv0 >= 32 ? 0xffffffffu : ((1u << nv0) - 1u)) >> (4 * hh); mw1 = (nv1 >= 32 ? 0xffffffffu : (nv1 <= 0 ? 0u : ((1u << nv1) - 1u))) >> (4 * hh);
#pragma unroll
                for (int q = 0; q < 16; ++q) { const int c = (q & 3) + 8 * (q >> 2);
                    float a0 = s0[q], a1 = s1[q];
                    asm("v_and_b32 %0, %0, %1" : "+v"(a0) : "v"(__builtin_amdgcn_sbfe((int)mw0, c, 1)));
                    asm("v_and_b32 %0, %0, %1" : "+v"(a1) : "v"(__builtin_amdgcn_sbfe((int)mw1, c, 1)));
                    s0[q] = a0; s1[q] = a1; }
            }
            f32x2_t ps2 = {0.f, 0.f};
#pragma unroll
            for (int q = 0; q < 16; q += 2) { ps2 += f32x2_t{s0[q], s0[q + 1]}; ps2 += f32x2_t{s1[q], s1[q + 1]}; }
            const float ps = half_sum(ps2.x + ps2.y);
            l_run = l_run * alpha + ps;
            if (__any(alpha != 1.0f)) {
#pragma unroll
                for (int dt = 0; dt < 4; ++dt)
#pragma unroll
                    for (int q = 0; q < 16; ++q) o[dt][q] *= alpha; }
            __builtin_amdgcn_sched_barrier(0);
            const LAS unsigned char* vb = Vl + buf * VTILE + r * VROW + hh * 16;
            h16x8 vf[2][4];
#define LDVG(G, dst) do { _Pragma("unroll") for (int dt_ = 0; dt_ < 4; ++dt_) dst[dt_] = *(const LAS h16x8*)(vb + (G) * 32 + dt_ * 32 * VROW); } while (0)
            LDVG(0, vf[0]);
#pragma unroll
            for (int G = 0; G < 4; ++G) { const int kbk = G >> 1, sg = G & 1;
                if (G + 1 < 4) LDVG(G + 1, vf[(G + 1) & 1]);
                u32x4 pw;
                if (kbk == 0) { pw.x = pkh(s0[8 * sg + 0], s0[8 * sg + 1]); pw.y = pkh(s0[8 * sg + 2], s0[8 * sg + 3]); pw.z = pkh(s0[8 * sg + 4], s0[8 * sg + 5]); pw.w = pkh(s0[8 * sg + 6], s0[8 * sg + 7]); }
                else { pw.x = pkh(s1[8 * sg + 0], s1[8 * sg + 1]); pw.y = pkh(s1[8 * sg + 2], s1[8 * sg + 3]); pw.z = pkh(s1[8 * sg + 4], s1[8 * sg + 5]); pw.w = pkh(s1[8 * sg + 6], s1[8 * sg + 7]); }
                const h16x8 pb = __builtin_bit_cast(h16x8, pw);
#pragma unroll
                for (int dt = 0; dt < 4; ++dt) o[dt] = __builtin_amdgcn_mfma_f32_32x32x16_f16(vf[G & 1][dt], pb, o[dt], 0, 0, 0);
                __builtin_amdgcn_sched_barrier(0);
            }
#undef LDVG
        }
        if (kt + 1 < nt) store_tile(buf ^ 1);
        __syncthreads();
        if (MODE == 1) asm volatile("; ATTN1_TILE_END"); else asm volatile("; ATTN0_TILE_END");
    };
    unsigned nx = 0u;
    for (int kt = 0; kt < nt_w; ++kt) { if (kt == nt - 1 && tid_ == 0) nx = __hip_atomic_fetch_add(qctr, 1u, __ATOMIC_RELAXED, __HIP_MEMORY_SCOPE_AGENT); tile(kt); }
    for (int kt = nt_w; kt < nt; ++kt) {
        if (kt == nt - 1 && tid_ == 0) nx = __hip_atomic_fetch_add(qctr, 1u, __ATOMIC_RELAXED, __HIP_MEMORY_SCOPE_AGENT);
        if (kt + 1 < nt) { load_tile(kt + 1); store_tile((kt & 1) ^ 1); }
        __syncthreads();
    }
    const float rl = __builtin_amdgcn_rcpf(l_run);
    h16* op = dry ? ((h16*)(ws + WS_X16) + (mb + tq) * 512 + head * 128) : (P + (mb + tq) * NP + (MODE == 0 ? C_OC : C_OA) + head * 128);
#pragma unroll
    for (int dt = 0; dt < 4; ++dt)
#pragma unroll
        for (int g4 = 0; g4 < 4; ++g4) { const int d0 = 32 * dt + 8 * g4 + 4 * hh;
            u32x2 w; w.x = pkh(o[dt][4 * g4 + 0] * rl, o[dt][4 * g4 + 1] * rl); w.y = pkh(o[dt][4 * g4 + 2] * rl, o[dt][4 * g4 + 3] * rl);
            *(u32x2*)(op + d0) = w; }
    if (tid_ == 0) MISC[16] = (nx < 1024u) ? (((nx & 7u) << 7) | (nx >> 3)) : 0xffffffffu;
    __syncthreads();
}
#ifndef MK_SINGLE
#define MK_SINGLE 1
#endif
#define PHEN(k) ((KMASK >> (k)) & 1)
constexpr int PH_PER_LAYER = 9, PH_FINAL = NL * PH_PER_LAYER, PH_COUNT = PH_FINAL + 1;

__device__ __forceinline__ Frame phase_frame(const Frame& F) {
    Frame P = F; unsigned z = 0u; asm volatile("" : "+v"(z)); const int ln = (int)__builtin_amdgcn_mbcnt_hi(~0u, __builtin_amdgcn_mbcnt_lo(~0u, z)); P.lane = ln; P.tid = F.wave * 64 + ln;
    unsigned long long w = (unsigned long long)F.ws; asm volatile("" : "+s"(w)); P.ws = (unsigned char*)(__attribute__((address_space(1))) unsigned char*)w;
    unsigned long long o = (unsigned long long)F.out; asm volatile("" : "+s"(o)); P.out = (float*)(__attribute__((address_space(1))) float*)o;
    int g = F.G, bd = F.bid, wv = F.wave; unsigned ld = (unsigned)(unsigned long long)F.lds; asm volatile("" : "+s"(g), "+s"(bd), "+s"(wv), "+s"(ld));
    P.G = g; P.bid = bd; P.wave = wv; P.lds = (LAS unsigned char*)ld; P.tid = wv * 64 + ln; return P; }
#ifndef REP_MASK
#define REP_MASK 0
#endif
#define REPN(k) (((REP_MASK >> (k)) & 1) ? 2 : 1)
#ifdef PROBE_SEL
#define STAMP(k) stamp_call(MISC + 8, (k), F.bid * NWAVES + F.wave)
#else
#define STAMP(k) do { } while (0)
#endif
template <int KMASK> __global__ void __launch_bounds__(NTHREADS, 2) mk_fwd(Args args) {
    extern __shared__ __attribute__((aligned(16))) unsigned char lds_raw[];
    Frame F;
    F.lds = (LAS unsigned char*)lds_raw;
    F.tid = threadIdx.x; F.lane = F.tid & 63; F.wave = __builtin_amdgcn_readfirstlane(F.tid >> 6);
    F.G = gridDim.x; F.bid = blockIdx.x; F.ws = args.ws; F.out = args.out;
    volatile LAS unsigned* MISC = (volatile LAS unsigned*)(F.lds + LDS_MISC);
    for (int u = F.tid; u < 128; u += NTHREADS) MISC[u] = 0u;
    if (F.tid < 20) *(LAS unsigned long long*)(F.lds + LDS_MISC + 512 + 8 * F.tid) = (unsigned long long)args.in[F.tid];
    __syncthreads();
    const int lo = args.ph_lo, hi = args.ph_hi;
#ifdef PROBE_SEL
    if (F.bid == 0 && F.tid == 0) { volatile LAS unsigned long long* T_ = (volatile LAS unsigned long long*)(MISC + 8 + 56); for (int i = 1; i < 24; ++i) T_[i] = 0ull; T_[0] = __builtin_amdgcn_s_memrealtime(); }
    __syncthreads();
#endif
    XcdBarrier bar; bar.bar = (unsigned*)(F.ws + WS_CTL) + 4096; bar.x = 0; bar.st = nullptr;
    if (hi - lo > 1) bar = xcd_barrier_post((unsigned*)(F.ws + WS_CTL) + 4096, MISC + 8);
#define IN(k) (lo <= (k) && (k) < hi)
#define SEAM(k) do { if ((k) + 1 < hi) { xcd_barrier_call(bar.bar, bar.x, bar.st, F.wave, (k) % PH_PER_LAYER, F.bid * NWAVES + F.wave); if ((REP_MASK >> 15) & 1) xcd_barrier_call(bar.bar, bar.x, bar.st, F.wave, (k) % PH_PER_LAYER, F.bid * NWAVES + F.wave); } } while (0)
    for (int l = 0; l < NL; ++l) {
        const int p0 = l * PH_PER_LAYER;
        if (PHEN(0) && IN(p0 + 0) && l == 0) { Frame Fp = phase_frame(F); unsigned char* ws = Fp.ws; asm volatile("; PHASE_MARK 0"); for (int rep = 0; rep < REPN(0); ++rep) ph0_convert(Fp, args, l); SEAM(p0 + 0); }
        if (PHEN(1) && IN(p0 + 1)) { Frame Fp = phase_frame(F); unsigned char* ws = Fp.ws; asm volatile("; PHASE_MARK 1");
            pg8::PlainSched S; S.T.init(M, NPROJ, Fp.G, Fp.bid); S.A = (const char*)(ws + WS_X16); S.B = (const char*)(ws + WS_WIN); S.lda2 = DM * 2; S.ldb2 = DM * 2;
            if ((REP_MASK >> 17) & 1) { pg8::EpiPlainDummy Ed{(h16*)(ws + WS_QC), NPROJ}; pg8::gemm_phase(Fp.lds, Fp.tid, DM, S.lda2, S.ldb2, S, Ed); }
            pg8::EpiScaleParts E{(h16*)(ws + WS_P), NP, (const float*)(ws + WS_RSA), (h16*)(ws + WS_HT), (h16*)(ws + WS_AVT), (h16*)(ws + WS_IKC), Fp.lds + pg8::STAGE_BYTES};
            for (int rep = 0; rep < REPN(1); ++rep) pg8::gemm_phase(Fp.lds, Fp.tid, DM, S.lda2, S.ldb2, S, E);
            SEAM(p0 + 1);
        }
        if (PHEN(2) && IN(p0 + 2)) { Frame Fp = phase_frame(F); unsigned char* ws = Fp.ws; asm volatile("; PHASE_MARK 2");
            if ((REP_MASK >> 27) & 1) { if (Fp.bid & 1) { const unsigned long long t0_ = __builtin_amdgcn_s_memrealtime(); while (__builtin_amdgcn_s_memrealtime() - t0_ < 10000ull) __builtin_amdgcn_s_sleep(8); } }
#ifdef PERT_SEL
            const unsigned long long pt2a_ = __builtin_amdgcn_s_memrealtime();
#endif
            for (int rep = 0; rep < REPN(2); ++rep) { if (!(rep == 1 && ((REP_MASK >> 25) & 1))) for (int u = Fp.bid; u < NB * 32; u += Fp.G) hgrn_b1_unit(Fp, u >> 5, u & 31);
#ifdef PERT_SEL
            const unsigned long long pt2b_ = __builtin_amdgcn_s_memrealtime();
            if (PERT_SEL == 8 && Fp.bid == 0 && Fp.tid == 0) { volatile LAS unsigned* PT = MISC + 32; PT[0] += (unsigned)(pt2b_ - pt2a_); PT[1] += 1u; }
#endif
            if (!(rep == 1 && ((REP_MASK >> 26) & 1))) ph2_rows(Fp);
#ifdef PERT_SEL
            if (PERT_SEL == 9 && Fp.bid == 0 && Fp.tid == 0) { volatile LAS unsigned* PT = MISC + 32; PT[0] += (unsigned)(__builtin_amdgcn_s_memrealtime() - pt2b_); PT[1] += 1u; }
#endif
            }
            SEAM(p0 + 2);
        }
        if (PHEN(3) && IN(p0 + 3)) { Frame Fp = phase_frame(F); unsigned char* ws = Fp.ws; asm volatile("; PHASE_MARK 3");
            { pg8::PlainSched S; S.T.init(M, 768, Fp.G, Fp.bid); S.A = (const char*)(ws + WS_P) + C_CQ * 2; S.B = (const char*)(ws + WS_WQB); S.lda2 = NP * 2; S.ldb2 = 384 * 2;
              pg8::EpiScaleRow<true> E{(h16*)(ws + WS_QC), 768, (const float*)(ws + WS_SMALL + SM_RSTDQ), (const float*)(ws + WS_COS), (const float*)(ws + WS_SIN)};
              for (int rep = 0; rep < REPN(3); ++rep) pg8::gemm_phase(Fp.lds, Fp.tid, 384, S.lda2, S.ldb2, S, E); }
        }

        if (PHEN(11) && IN(p0 + 3)) { Frame Fp = phase_frame(F); unsigned char* ws = Fp.ws; asm volatile("; PHASE_MARK 11");
            { pg8::PlainSched S; S.T.init(M, 1024, Fp.G, Fp.bid); S.A = (const char*)(ws + WS_P) + C_CKV * 2; S.B = (const char*)(ws + WS_WKVB); S.lda2 = NP * 2; S.ldb2 = 256 * 2;
              pg8::EpiKV E{(h16*)(ws + WS_KN), (h16*)(ws + WS_VCT), (const float*)(ws + WS_SMALL + SM_RSTDKV)};
              for (int rep = 0; rep < REPN(11); ++rep) pg8::gemm_phase(Fp.lds, Fp.tid, 256, S.lda2, S.ldb2, S, E); }
        }

        if (PHEN(10) && IN(p0 + 3)) { Frame Fp = phase_frame(F); unsigned char* ws = Fp.ws; asm volatile("; PHASE_MARK 10");
            for (int rep = 0; rep < REPN(10); ++rep) { int dry = (rep + 1 < REPN(10)); asm volatile("" : "+s"(dry));
            if (!(dry && ((REP_MASK >> 23) & 1))) for (int u = Fp.bid; u < NB * 128; u += Fp.G) { const int j = u >> 8, i = u & 255, gi = i >> 3; const int g = j * 32 + ((j & 1) ? (31 - gi) : gi); score_select_unit(Fp, i & 7, g); }
            if (!(dry && ((REP_MASK >> 24) & 1))) for (int u = Fp.bid; u < 256; u += Fp.G) hgrn_scan_unit(Fp, u, dry); }
        }
        if ((PHEN(3) || PHEN(10) || PHEN(11)) && IN(p0 + 3)) { SEAM(p0 + 3); }
        if (PHEN(4) && IN(p0 + 4)) { Frame Fp = phase_frame(F); unsigned char* ws = Fp.ws; asm volatile("; PHASE_MARK 4");
            for (int rep = 0; rep < REPN(4); ++rep) { int dry = (rep + 1 < REPN(4)); asm volatile("" : "+s"(dry));
            unsigned* qctr = (unsigned*)(ws + WS_CTL) + 8192 + 64 * l + 16 * rep;
            if (Fp.tid == 0) { const unsigned uu = __hip_atomic_fetch_add(qctr, 1u, __ATOMIC_RELAXED, __HIP_MEMORY_SCOPE_AGENT); MISC[16] = (uu < 1024u) ? (((uu & 7u) << 7) | (uu >> 3)) : 0xffffffffu; }
            __syncthreads();
            int pre = 0;
            float lb0, lb1; { const float* lbv = (const float*)(ws + WS_SMALL + SM_LB); const int colp = Fp.tid & 255; lb0 = lbv[colp]; lb1 = lbv[256 + colp]; }
            for (;;) {
                const unsigned code = MISC[16];
                if (code == 0xffffffffu) break;
                const int ub = (int)(code >> 7), u = (int)(code & 127u);
                int kind, uq, uh = 0;
                if (u < 16) { kind = 1; uq = 31 - u; }
                else if (u < 64) { const int v = u - 16, k = v / 6, w = v - 6 * k;
                    if (w < 4) { kind = 0; uh = w; uq = 7 - k; } else { kind = 1; uq = 15 - 2 * k - (w - 4); } }
                else { kind = 2; uq = (u - 64) >> 1; uh = (u - 64) & 1; }
#ifdef PERT_SEL
                const unsigned long long pt0_ = __builtin_amdgcn_s_memrealtime();
#endif
                if (kind == 2) pre = hgrn_b3_unit(Fp, args, ub, uq, l, uh, dry, qctr, MISC, pre, uh ? lb1 : lb0);
                else if (kind == 0) attn_unit<0>(Fp, args, ub, uh, uq, dry, qctr, MISC); else attn_unit<1>(Fp, args, ub, 0, uq, dry, qctr, MISC);
#ifdef PERT_SEL
                if (Fp.bid == 0 && Fp.tid == 0 && kind == PERT_SEL) { volatile LAS unsigned* PT = MISC + 32; const unsigned dt_ = (unsigned)(__builtin_amdgcn_s_memrealtime() - pt0_);
                    PT[0] += dt_; PT[1] += (kind == 0) ? (unsigned)(4 * uq + 4) : ((kind == 1) ? (unsigned)(uq + 1) : 1u); }
#endif
            }
            __syncthreads(); }
            SEAM(p0 + 4);
        }
        if (PHEN(5) && IN(p0 + 5)) { Frame Fp = phase_frame(F); unsigned char* ws = Fp.ws; asm volatile("; PHASE_MARK 5");
            pg8::Cat3Sched S; S.T.init(M, DM, Fp.G, Fp.bid); S.A = (const char*)(ws + WS_P); S.B = (const char*)(ws + WS_WUP); S.lda2 = NP * 2; S.ldb2 = 1536 * 2;
            pg8::EpiGate3 E{(h16*)(ws + WS_MIX), (const h16*)(ws + WS_P) + C_G, NP};
            for (int rep = 0; rep < REPN(5); ++rep) pg8::gemm_phase(Fp.lds, Fp.tid, 1536, S.lda2, S.ldb2, S, E);
            SEAM(p0 + 5);
        }
        if (PHEN(6) && IN(p0 + 6)) { Frame Fp = phase_frame(F); unsigned char* ws = Fp.ws; asm volatile("; PHASE_MARK 6");
            pg8::PlainSched S; S.T.init(M, DM, Fp.G, Fp.bid); S.A = (const char*)(ws + WS_MIX); S.B = (const char*)(ws + WS_WOUT); S.lda2 = DM * 2; S.ldb2 = DM * 2;
            if (REPN(6) == 2) { pg8::EpiResidual Ed{(h16*)(ws + WS_HT), (float*)(ws + WS_HT + 32 * MiB)};
                pg8::gemm_phase(Fp.lds, Fp.tid, DM, S.lda2, S.ldb2, S, Ed); }
            pg8::EpiResidual E{(h16*)(ws + WS_X16), (float*)(ws + WS_RSF)};
            pg8::gemm_phase(Fp.lds, Fp.tid, DM, S.lda2, S.ldb2, S, E);
            SEAM(p0 + 6);
        }
        if (PHEN(7) && IN(p0 + 7)) { Frame Fp = phase_frame(F); unsigned char* ws = Fp.ws; asm volatile("; PHASE_MARK 7");
            pg8::PlainSched S; S.T.init(M, 2 * DFF, Fp.G, Fp.bid); S.A = (const char*)(ws + WS_X16); S.B = (const char*)(ws + ((l & 1) ? WS_WGU2 : WS_WGU)); S.lda2 = DM * 2; S.ldb2 = DM * 2;
            pg8::EpiSwiGLU E{(h16*)(ws + WS_ACT), (const float*)(ws + WS_RSF), Fp.lds + pg8::STAGE_BYTES};
            for (int rep = 0; rep < REPN(7); ++rep) pg8::gemm_phase(Fp.lds, Fp.tid, DM, S.lda2, S.ldb2, S, E);
            { const int busy = 22 * (M / 256) - ((22 * (M / 256) - 1) / Fp.G) * Fp.G;
#ifdef PERT_SEL
              const unsigned long long pt7_ = __builtin_amdgcn_s_memrealtime();
#endif
              if (l + 1 < NL && busy < Fp.G && Fp.bid >= busy) ph0_items(Fp, args, l + 1, 0, PH0_NIT, (Fp.bid - busy) * NWAVES + Fp.wave, (Fp.G - busy) * NWAVES);
#ifdef PERT_SEL
              if (PERT_SEL == 7 && l + 1 < NL && Fp.bid == Fp.G - 1 && Fp.tid == 0) { volatile LAS unsigned* PT = MISC + 32; PT[0] += (unsigned)(__builtin_amdgcn_s_memrealtime() - pt7_); PT[1] += 1u; }
#endif
              }
            SEAM(p0 + 7);
        }
        if (PHEN(8) && IN(p0 + 8)) { Frame Fp = phase_frame(F); unsigned char* ws = Fp.ws; asm volatile("; PHASE_MARK 8");
            pg8::PlainSched S; S.T.init(M, DM, Fp.G, Fp.bid); S.A = (const char*)(ws + WS_ACT); S.B = (const char*)(ws + ((l & 1) ? WS_WDN2 : WS_WDN)); S.lda2 = DFF * 2; S.ldb2 = DFF * 2;
            if (REPN(8) == 2) { pg8::EpiResidual Ed{(h16*)(ws + WS_HT), (float*)(ws + WS_HT + 32 * MiB)};
                pg8::gemm_phase(Fp.lds, Fp.tid, DFF, S.lda2, S.ldb2, S, Ed); }
            pg8::EpiResidual E{(h16*)(ws + WS_X16), (float*)(ws + WS_RSA)};
            pg8::gemm_phase(Fp.lds, Fp.tid, DFF, S.lda2, S.ldb2, S, E);
            if (l + 1 < NL) { const int busy = 22 * (M / 256) - ((22 * (M / 256) - 1) / Fp.G) * Fp.G; ph0_convert(Fp, args, l + 1, busy < Fp.G ? PH0_NIT : 0); }
            SEAM(p0 + 8);
        }
    }
#ifdef PROBE_SEL
    {
        float* pv = (float*)(F.ws + WS_CTL + 512 * 1024);
        if (F.bid == 0 && F.wave == 0 && lane_id() == 0) { volatile LAS unsigned long long* T_ = (volatile LAS unsigned long long*)(MISC + 8 + 56); unsigned long long s = 0ull;
            for (int i = 0; i < 23; ++i) if ((PROBE_SEL >> i) & 1) s += T_[1 + i];
            __hip_atomic_store(pv, sqrtf((float)s * 0.01f / PROBE_SCALE), __ATOMIC_RELAXED, __HIP_MEMORY_SCOPE_AGENT); }
        xcd_barrier_call(bar.bar, bar.x, bar.st, F.wave, 20, 1);
        const float av = __hip_atomic_load(pv, __ATOMIC_RELAXED, __HIP_MEMORY_SCOPE_AGENT);
        Frame Fp = phase_frame(F);
        for (size_t i = (size_t)Fp.bid * NTHREADS + Fp.tid; i < (size_t)M * DM; i += (size_t)Fp.G * NTHREADS) Fp.out[i] = av;
        return;
    }
#endif
#ifdef PERT_SEL
    float pert_scale = 1.0f;
    if (IN(PH_FINAL)) { float* pv = (float*)(F.ws + WS_CTL + 768 * 1024);
        if (F.bid == (PERT_SEL == 7 ? F.G - 1 : 0) && F.wave == 0 && lane_id() == 0) { volatile LAS unsigned* PT = MISC + 32; const float avg_us = PT[1] ? (float)PT[0] * 0.01f / (float)PT[1] : 0.f;
            __hip_atomic_store(pv, sqrtf(1e-4f * avg_us / PERT_SCALE), __ATOMIC_RELAXED, __HIP_MEMORY_SCOPE_AGENT); }
        xcd_barrier_call(bar.bar, bar.x, bar.st, F.wave, 20, 1);
        pert_scale = 1.0f + __hip_atomic_load(pv, __ATOMIC_RELAXED, __HIP_MEMORY_SCOPE_AGENT); }
#endif
    if (PHEN(9) && IN(PH_FINAL)) { Frame Fp = phase_frame(F); unsigned char* ws = Fp.ws; asm volatile("; PHASE_MARK 9");
        const int gw = Fp.bid * NWAVES + Fp.wave, NGW = Fp.G * NWAVES; const f32x4* gn = (const f32x4*)arg_in(Fp.lds, I_FINAL);
        f32x4 gnv[4];
#pragma unroll
        for (int j = 0; j < 4; ++j) gnv[j] = gn[Fp.lane + 64 * j];
        for (int m0 = gw; m0 < M; m0 += 4 * NGW) {
            h16x4 hv[4][4];
#pragma unroll
            for (int u = 0; u < 4; ++u) { const int m = m0 + u * NGW < M ? m0 + u * NGW : m0; const h16x4* xh = (const h16x4*)((const h16*)(ws + WS_X16) + (size_t)m * DM) + Fp.lane;
#pragma unroll
                for (int j = 0; j < 4; ++j) hv[u][j] = xh[64 * j]; }
#pragma unroll
            for (int u = 0; u < 4; ++u) { const int m = m0 + u * NGW; if (m >= M) break;
                f32x4* xr = (f32x4*)(Fp.out + (size_t)m * DM) + Fp.lane; f32x4 v[4]; float ss = 0.f;
#pragma unroll
                for (int j = 0; j < 4; ++j) { v[j][0] = (float)hv[u][j][0]; v[j][1] = (float)hv[u][j][1]; v[j][2] = (float)hv[u][j][2]; v[j][3] = (float)hv[u][j][3]; ss += (v[j][0] * v[j][0] + v[j][1] * v[j][1]) + (v[j][2] * v[j][2] + v[j][3] * v[j][3]); }
                float rs = __builtin_amdgcn_rsqf(wave_sum(ss) * (1.0f / DM) + EPS);
#ifdef PERT_SEL
                rs *= pert_scale;
#endif
#pragma unroll
                for (int j = 0; j < 4; ++j) xr[64 * j] = v[j] * rs * gnv[j]; } }
    }
#undef IN
#undef SEAM
}

extern "C" void kernel_launch(void* const* d_in, const int* in_sizes, int n_in, void* d_out, int out_size, void* d_ws, size_t ws_size, hipStream_t stream) {
    static int grid = 0;
    if (grid == 0) {
        if (n_in != 20 || out_size != M * DM || ws_size < WS_END) { fprintf(stderr, "kernel_launch: unexpected shapes (n_in %d out %d ws %zu need %zu)\n", n_in, out_size, ws_size, (size_t)WS_END); grid = -1; return; }
        int dev = 0, cus = 0, per_cu = 0;
        if (hipGetDevice(&dev) != hipSuccess || hipDeviceGetAttribute(&cus, hipDeviceAttributeMultiprocessorCount, dev) != hipSuccess) { grid = -1; return; }
#if MK_SINGLE
        if (hipFuncSetAttribute((const void*)mk_fwd<0xfff>, hipFuncAttributeMaxDynamicSharedMemorySize, LDS_BYTES) != hipSuccess) { fprintf(stderr, "kernel_launch: hipFuncSetAttribute failed\n"); grid = -1; return; }
        if (hipOccupancyMaxActiveBlocksPerMultiprocessor(&per_cu, (const void*)mk_fwd<0xfff>, NTHREADS, LDS_BYTES) != hipSuccess || per_cu < 1) { fprintf(stderr, "kernel_launch: occupancy query says %d\n", per_cu); grid = -1; return; }
#else
        { const void* fns[12] = {(const void*)mk_fwd<1024>, (const void*)mk_fwd<2048>, (const void*)mk_fwd<1>, (const void*)mk_fwd<2>, (const void*)mk_fwd<4>, (const void*)mk_fwd<8>, (const void*)mk_fwd<16>, (const void*)mk_fwd<32>, (const void*)mk_fwd<64>, (const void*)mk_fwd<128>, (const void*)mk_fwd<256>, (const void*)mk_fwd<512>};
          for (int i = 0; i < 12; ++i) if (hipFuncSetAttribute(fns[i], hipFuncAttributeMaxDynamicSharedMemorySize, LDS_BYTES) != hipSuccess) { fprintf(stderr, "kernel_launch: hipFuncSetAttribute failed\n"); grid = -1; return; } }
        (void)per_cu;
#endif
        (void)hipGetLastError();
        grid = cus;
    }
    if (grid < 0) return;
#if defined(PROBE_SEL) || defined(PERT_SEL)
    (void)hipMemsetAsync((char*)d_ws + WS_CTL, 0, CTL_BYTES, stream);
#else
    (void)hipMemsetAsync((char*)d_ws + WS_CTL, 0, 64 * 1024, stream);
#endif
    Args a{};
    for (int i = 0; i < 20; ++i) a.in[i] = (const float*)d_in[i];
    a.out = (float*)d_out; a.ws = (unsigned char*)d_ws;
#if MK_SINGLE
    a.ph_lo = 0; a.ph_hi = PH_COUNT;
    hipLaunchKernelGGL(mk_fwd<0xfff>, dim3(grid), dim3(NTHREADS), LDS_BYTES, stream, a);
#else
    for (int p = 0; p < PH_COUNT; ++p) { a.ph_lo = p; a.ph_hi = p + 1; const int k = (p == PH_FINAL) ? 9 : (p % PH_PER_LAYER);
        switch (k) {
            case 0: hipLaunchKernelGGL(mk_fwd<1>, dim3(grid), dim3(NTHREADS), LDS_BYTES, stream, a); break;
            case 1: hipLaunchKernelGGL(mk_fwd<2>, dim3(grid), dim3(NTHREADS), LDS_BYTES, stream, a); break;
            case 2: hipLaunchKernelGGL(mk_fwd<4>, dim3(grid), dim3(NTHREADS), LDS_BYTES, stream, a); break;
            case 3: hipLaunchKernelGGL(mk_fwd<8>, dim3(grid), dim3(NTHREADS), LDS_BYTES, stream, a); hipLaunchKernelGGL(mk_fwd<2048>, dim3(grid), dim3(NTHREADS), LDS_BYTES, stream, a); hipLaunchKernelGGL(mk_fwd<1024>, dim3(grid), dim3(NTHREADS), LDS_BYTES, stream, a); break;
            case 4: hipLaunchKernelGGL(mk_fwd<16>, dim3(grid), dim3(NTHREADS), LDS_BYTES, stream, a); break;
            case 5: hipLaunchKernelGGL(mk_fwd<32>, dim3(grid), dim3(NTHREADS), LDS_BYTES, stream, a); break;
            case 6: hipLaunchKernelGGL(mk_fwd<64>, dim3(grid), dim3(NTHREADS), LDS_BYTES, stream, a); break;
            case 7: hipLaunchKernelGGL(mk_fwd<128>, dim3(grid), dim3(NTHREADS), LDS_BYTES, stream, a); break;
            case 8: hipLaunchKernelGGL(mk_fwd<256>, dim3(grid), dim3(NTHREADS), LDS_BYTES, stream, a); break;
            default: hipLaunchKernelGGL(mk_fwd<512>, dim3(grid), dim3(NTHREADS), LDS_BYTES, stream, a); break;
        } }
#endif
}
```
